# Optimizing an MI355X kernel written in HIP

```python
import math
import jax, jax.numpy as jnp
from jax import lax
import numpy as np

D_MODEL = 1024
BATCH = 8
SEQ = 4096
DEPTH = 2

D_MIX = D_MODEL
D_FOURIER = D_MIX // 4
N_FOURIER_HEADS = 4
FOURIER_HEAD_DIM = D_FOURIER // N_FOURIER_HEADS
D_DIFF = D_MIX // 2
N_DIFF_HEADS = 4
DIFF_HEAD_DIM = D_DIFF // (2 * N_DIFF_HEADS)
DIFF_V_DIM = 2 * DIFF_HEAD_DIM
D_POOL = D_MIX - D_FOURIER - D_DIFF
POOL_WINDOWS = (2, 4, 8, 16)
N_POOL_GROUPS = len(POOL_WINDOWS)
POOL_GROUP_DIM = D_POOL // N_POOL_GROUPS
D_IN_PROJ = D_FOURIER + 3 * D_DIFF + D_POOL
D_FF = ((8 * D_MODEL // 3 + 127) // 128) * 128
N_SUBLAYERS = 3
ROPE_THETA = 10000.0
Q_BLOCK = 128
NORM_EPS = 1e-6
SUBLN_EPS = 1e-5
MACARON_WEIGHT = 0.5

kernel_name = "hybrid_fourier_diffattn_pool_macaron_encoder"


def rms_norm(x, g, eps=NORM_EPS):
    xf = x.astype(jnp.float32)
    y = xf * lax.rsqrt(jnp.mean(xf * xf, axis=-1, keepdims=True) + eps)
    return (y * g.astype(jnp.float32)).astype(x.dtype)


def modulate(h, shift, scale):
    return h * (1 + scale[:, None, :]) + shift[:, None, :]


def rope_tables(positions):
    inv = 1.0 / (ROPE_THETA ** (jnp.arange(0, DIFF_HEAD_DIM, 2, dtype=jnp.float32) / DIFF_HEAD_DIM))
    ang = positions.astype(jnp.float32)[:, None] * inv[None, :]
    ang = jnp.concatenate([ang, ang], axis=-1)
    return jnp.cos(ang), jnp.sin(ang)


def apply_rope(t, cos, sin):
    t1, t2 = jnp.split(t, 2, axis=-1)
    rot = jnp.concatenate([-t2, t1], axis=-1)
    return (t * cos[None, :, None, :] + rot * sin[None, :, None, :]).astype(t.dtype)


def swiglu(h, w_gu, w_down):
    g, u = jnp.split(h @ w_gu, 2, axis=-1)
    return (jax.nn.silu(g) * u) @ w_down


def fourier_mixer(u, w_f):
    B, S, _ = u.shape
    uh = u.reshape(B, S, N_FOURIER_HEADS, FOURIER_HEAD_DIM).astype(jnp.float32)
    f = jnp.fft.fft2(uh, axes=(1, 3), norm="ortho").real
    return f.reshape(B, S, D_FOURIER).astype(u.dtype) @ w_f


def diff_attention(q, k, v, lam, lambda_init, g_subln, cos, sin):
    B, S, _ = q.shape
    H, d = N_DIFF_HEADS, DIFF_HEAD_DIM
    q = apply_rope(q.reshape(B, S, 2 * H, d), cos, sin)
    k = apply_rope(k.reshape(B, S, 2 * H, d), cos, sin)
    q = q.reshape(B, S, H, 2, d).transpose(0, 2, 3, 1, 4)
    k = k.reshape(B, S, H, 2, d).transpose(0, 2, 3, 1, 4)
    v = v.reshape(B, S, H, DIFF_V_DIM).transpose(0, 2, 1, 3)
    nblk = S // Q_BLOCK
    qb = q.reshape(B, H, 2, nblk, Q_BLOCK, d).transpose(3, 0, 1, 2, 4, 5)
    scale = d ** -0.5

    def block(q_blk):
        s = jnp.einsum('bhmqd,bhmkd->bhmqk', q_blk, k).astype(jnp.float32) * scale
        p = jax.nn.softmax(s, axis=-1)
        a = p[:, :, 0] - lam * p[:, :, 1]
        return jnp.einsum('bhqk,bhkv->bhqv', a.astype(v.dtype), v)

    o = lax.map(block, qb)
    o = o.transpose(1, 0, 3, 2, 4).reshape(B, S, H, DIFF_V_DIM)
    o = rms_norm(o, g_subln, SUBLN_EPS) * (1.0 - lambda_init)
    return o.reshape(B, S, D_DIFF)


def pool_mixer(u, w_pool, pool_scale):
    B, S, _ = u.shape
    uf = u.astype(jnp.float32)
    pos = jnp.arange(S)
    outs = []
    for g, w in enumerate(POOL_WINDOWS):
        xg = uf[..., g * POOL_GROUP_DIM:(g + 1) * POOL_GROUP_DIM]
        half = w // 2
        xp = jnp.pad(xg, ((0, 0), (half + 1, half), (0, 0)))
        cs = jnp.cumsum(xp, axis=1)
        win_sum = cs[:, w:w + S] - cs[:, 0:S]
        count = (jnp.minimum(pos + half, S) - jnp.maximum(pos - half, 0)).astype(jnp.float32)
        outs.append(win_sum / count[None, :, None] - xg)
    pooled = jnp.stack(outs, axis=2)
    y = jnp.einsum('bsgc,gcd->bsgd', pooled.astype(u.dtype), w_pool).reshape(B, S, D_POOL)
    return y * pool_scale


def setup_inputs(seed: int = 0) -> dict:
    key = jax.random.key(seed)
    ks = jax.random.split(key, 20)
    L, D = DEPTH, D_MODEL

    def dense(k, shape, fan_in):
        return jax.random.normal(k, shape, jnp.float32) * (fan_in ** -0.5)

    def noise(k, shape, s):
        return s * jax.random.normal(k, shape, jnp.float32)

    return {
        "x": jax.random.normal(ks[0], (BATCH, SEQ, D), jnp.float32),
        "c": jax.random.normal(ks[1], (BATCH, D), jnp.float32),
        "positions": jnp.arange(SEQ, dtype=jnp.int32),
        "w_ada": dense(ks[2], (L, D, N_SUBLAYERS * 3 * D), D),
        "b_ada": noise(ks[3], (L, N_SUBLAYERS * 3 * D), 0.01),
        "g_pre": 1.0 + noise(ks[4], (L, N_SUBLAYERS, D), 0.02),
        "g_post": 1.0 + noise(ks[5], (L, N_SUBLAYERS, D), 0.02),
        "w_ff_gu": dense(ks[6], (L, 2, D, 2 * D_FF), D),
        "w_ff_down": dense(ks[7], (L, 2, D_FF, D), D_FF),
        "w_in": dense(ks[8], (L, D, D_IN_PROJ), D),
        "w_fourier": dense(ks[9], (L, D_FOURIER, D_FOURIER), D_FOURIER),
        "lambda_q1": noise(ks[10], (L, DIFF_HEAD_DIM), 0.1),
        "lambda_k1": noise(ks[11], (L, DIFF_HEAD_DIM), 0.1),
        "lambda_q2": noise(ks[12], (L, DIFF_HEAD_DIM), 0.1),
        "lambda_k2": noise(ks[13], (L, DIFF_HEAD_DIM), 0.1),
        "g_subln": 1.0 + noise(ks[14], (L, DIFF_V_DIM), 0.02),
        "w_pool": dense(ks[15], (L, N_POOL_GROUPS, POOL_GROUP_DIM, POOL_GROUP_DIM), POOL_GROUP_DIM),
        "pool_scale": 1.0 + noise(ks[16], (L, D_POOL), 0.1),
        "w_out": dense(ks[17], (L, D_MIX, D), D_MIX),
    }


def reference(x, c, positions, w_ada, b_ada, g_pre, g_post, w_ff_gu, w_ff_down, w_in,
              w_fourier, lambda_q1, lambda_k1, lambda_q2, lambda_k2, g_subln, w_pool,
              pool_scale, w_out):
    B = x.shape[0]
    D = D_MODEL
    cos, sin = rope_tables(positions)
    c_act = jax.nn.silu(c)
    splits = [D_FOURIER, D_FOURIER + D_DIFF, D_FOURIER + 2 * D_DIFF, D_FOURIER + 3 * D_DIFF]
    for l in range(DEPTH):
        ada = (c_act @ w_ada[l] + b_ada[l]).reshape(B, N_SUBLAYERS, 3, D)
        shift, scale, gate = ada[:, :, 0], ada[:, :, 1], ada[:, :, 2]

        h = modulate(rms_norm(x, g_pre[l, 0]), shift[:, 0], scale[:, 0])
        y = swiglu(h, w_ff_gu[l, 0], w_ff_down[l, 0])
        x = x + MACARON_WEIGHT * gate[:, 0][:, None, :] * rms_norm(y, g_post[l, 0])

        h = modulate(rms_norm(x, g_pre[l, 1]), shift[:, 1], scale[:, 1])
        proj = h @ w_in[l]
        u_f, q, k, v, u_p = jnp.split(proj, splits, axis=-1)
        lambda_init = 0.8 - 0.6 * math.exp(-0.3 * l)
        lam = (jnp.exp(jnp.sum(lambda_q1[l].astype(jnp.float32) * lambda_k1[l].astype(jnp.float32)))
               - jnp.exp(jnp.sum(lambda_q2[l].astype(jnp.float32) * lambda_k2[l].astype(jnp.float32)))
               + lambda_init)
        y_f = fourier_mixer(u_f, w_fourier[l])
        y_d = diff_attention(q, k, v, lam, lambda_init, g_subln[l], cos, sin)
        y_p = pool_mixer(u_p, w_pool[l], pool_scale[l])
        y = jnp.concatenate([y_f, y_d, y_p], axis=-1) @ w_out[l]
        x = x + gate[:, 1][:, None, :] * rms_norm(y, g_post[l, 1])

        h = modulate(rms_norm(x, g_pre[l, 2]), shift[:, 2], scale[:, 2])
        y = swiglu(h, w_ff_gu[l, 1], w_ff_down[l, 1])
        x = x + MACARON_WEIGHT * gate[:, 2][:, None, :] * rms_norm(y, g_post[l, 2])
    return x
```

```cpp
#include <hip/hip_runtime.h>
#include <hip/hip_cooperative_groups.h>
#include <cstdio>
#include <cstdint>
namespace cg = cooperative_groups;
namespace pg8 {
#define PG8_LAS __attribute__((address_space(3)))
typedef unsigned short bf16_t;
typedef short bf16x8 __attribute__((ext_vector_type(8)));
typedef float f32x4 __attribute__((ext_vector_type(4)));
typedef unsigned u32x4 __attribute__((ext_vector_type(4)));
constexpr int BM = 256, BK = 64, HALF = 128, HTB = HALF * BK * 2  , STAGE_BYTES = 8 * HTB, NXCD = 8, WGM = 8;

__host__ __device__ __forceinline__ int lds_byte(int r, int c) { const int st = (r >> 4) * 2 + (c >> 5), rr = r & 15, cc = c & 31, ob = rr * 64 + cc * 2; return st * 1024 + (ob ^ (((ob >> 9) & 1) << 5)); }
__host__ __device__ __forceinline__ void stage_rc(int b, int& R, int& C) { const int st = b / 1024, sb = b % 1024, swz = sb ^ (((sb >> 9) & 1) << 5); R = (st >> 1) * 16 + swz / 64; C = (st & 1) * 32 + (swz % 64) / 2; }
__host__ __device__ __forceinline__ int perm32(int rho) { const int n = rho >> 4, i = rho & 15; return 8 * (i >> 2) + 4 * n + (i & 3); }

struct Unit { int pm, pn; };
struct Gemm { const bf16_t* A; const bf16_t* Bt; int M, N, K; };

struct StaticOrder {
    int nM, nN, nwg, G, c;
    __host__ __device__ void init(int M, int N, int G_, int c_) { nM = M / BM; nN = N / BM; nwg = nM * nN; G = G_; c = c_; }
    __host__ __device__ bool next(int i, Unit& u) const {
        const long L = (long)i * G + c; if (L >= nwg) return false;
        int wgid = (int)L; { const int q = nwg / NXCD, r = nwg % NXCD, xcd = wgid % NXCD, off = wgid / NXCD; wgid = (xcd < r ? xcd * (q + 1) : r * (q + 1) + (xcd - r) * q) + off; }
        const int nig = WGM * nN, gid = wgid / nig, fm = gid * WGM, gsz = (nM - fm) < WGM ? (nM - fm) : WGM;
        u.pm = fm + ((wgid % nig) % gsz); u.pn = (wgid % nig) / gsz; return true;
    }
    __device__ __forceinline__ void a_ready(const Unit&) const {}
    __device__ __forceinline__ void done(const Unit&) const {}
};


typedef float f32x2 __attribute__((ext_vector_type(2)));
typedef __bf16 bf16x2v __attribute__((ext_vector_type(2)));
__device__ __forceinline__ unsigned cvt_pk_bf16(float lo, float hi) { f32x2 v = {lo, hi}; bf16x2v b = __builtin_convertvector(v, bf16x2v); return __builtin_bit_cast(unsigned, b); }

struct EpiBf16 {
    static constexpr bool PERM = true, AFTER_DRAIN = false;
    bf16_t* O; int ldc; int split_cols; size_t split_stride;
    __device__ __forceinline__ void operator()(const f32x4 (&acc)[2][2][4][2], const Unit& u, int wr, int wc, int fr, int fq) const {
        const int row0 = u.pm * BM + wr * 64 + fr; int colt = u.pn * BM; bf16_t* base = O;
        if (split_cols) { const int t = colt / split_cols; base += (size_t)t * split_stride; colt -= t * split_cols; }
        const int col0 = colt + wc * 32 + 8 * fq;
#pragma unroll
        for (int ai = 0; ai < 2; ++ai)
#pragma unroll
            for (int m = 0; m < 4; ++m) { bf16_t* rowp = base + (size_t)(row0 + ai * HALF + m * 16) * ldc + col0;
#pragma unroll
                for (int bj = 0; bj < 2; ++bj) { const f32x4 v0 = acc[ai][bj][m][0], v1 = acc[ai][bj][m][1];
                    u32x4 w; w.x = cvt_pk_bf16(v0[0], v0[1]); w.y = cvt_pk_bf16(v0[2], v0[3]); w.z = cvt_pk_bf16(v1[0], v1[1]); w.w = cvt_pk_bf16(v1[2], v1[3]);
                    *(u32x4*)(rowp + bj * HALF) = w; } }
    }
};

struct EpiSwiglu {
    static constexpr bool PERM = true, AFTER_DRAIN = false;
    bf16_t* O; int ldc;
    __device__ __forceinline__ void operator()(const f32x4 (&acc)[2][2][4][2], const Unit& u, int wr, int wc, int fr, int fq) const {
        const int row0 = u.pm * BM + wr * 64 + fr; const int col0 = u.pn * HALF + wc * 32 + 8 * fq;
#pragma unroll
        for (int ai = 0; ai < 2; ++ai)
#pragma unroll
            for (int m = 0; m < 4; ++m) { bf16_t* rowp = O + (size_t)(row0 + ai * HALF + m * 16) * ldc + col0;
                float h[8];
#pragma unroll
                for (int n = 0; n < 2; ++n)
#pragma unroll
                    for (int j = 0; j < 4; ++j) { const float g = acc[ai][0][m][n][j], up = acc[ai][1][m][n][j];
                        const float e = __builtin_amdgcn_exp2f(-1.4426950408889634f * g); h[n * 4 + j] = g * up * __builtin_amdgcn_rcpf(1.0f + e); }
                u32x4 w; w.x = cvt_pk_bf16(h[0], h[1]); w.y = cvt_pk_bf16(h[2], h[3]); w.z = cvt_pk_bf16(h[4], h[5]); w.w = cvt_pk_bf16(h[6], h[7]);
                *(u32x4*)rowp = w; }
    }
};

struct EpiRope {
    static constexpr bool PERM = true, AFTER_DRAIN = false;
    bf16_t* O; const float* rope;
    __device__ __forceinline__ void operator()(const f32x4 (&acc)[2][2][4][2], const Unit& u, int wr, int wc, int fr, int fq) const {
        const int row0 = u.pm * BM + wr * 64 + fr; const int col0 = u.pn * BM + wc * 32 + 8 * fq; const bool rot = u.pn < 4;
#pragma unroll
        for (int ai = 0; ai < 2; ++ai)
#pragma unroll
            for (int m = 0; m < 4; ++m) { const int row = row0 + ai * HALF + m * 16; bf16_t* rowp = O + (size_t)row * 1280 + col0; const int s = row & 4095;
#pragma unroll
                for (int bj = 0; bj < 2; ++bj) { f32x4 v0 = acc[ai][bj][m][0], v1 = acc[ai][bj][m][1];
                    if (rot) { const int i0 = ((col0 + bj * HALF) & 63) >> 1; const f32x4* rp = (const f32x4*)(rope + ((size_t)s * 32 + i0) * 2);
                        const f32x4 c0 = rp[0], c1 = rp[1];
                        f32x4 o0, o1;
                        o0[0] = v0[0] * c0[0] - v0[1] * c0[1]; o0[1] = v0[1] * c0[0] + v0[0] * c0[1];
                        o0[2] = v0[2] * c0[2] - v0[3] * c0[3]; o0[3] = v0[3] * c0[2] + v0[2] * c0[3];
                        o1[0] = v1[0] * c1[0] - v1[1] * c1[1]; o1[1] = v1[1] * c1[0] + v1[0] * c1[1];
                        o1[2] = v1[2] * c1[2] - v1[3] * c1[3]; o1[3] = v1[3] * c1[2] + v1[2] * c1[3];
                        v0 = o0; v1 = o1; }
                    u32x4 w; w.x = cvt_pk_bf16(v0[0], v0[1]); w.y = cvt_pk_bf16(v0[2], v0[3]); w.z = cvt_pk_bf16(v1[0], v1[1]); w.w = cvt_pk_bf16(v1[2], v1[3]);
                    *(u32x4*)(rowp + bj * HALF) = w; } }
    }
};

struct EpiChanMajor {
    static constexpr bool PERM = true, AFTER_DRAIN = false;
    bf16_t* FT; bf16_t* VT;
    __device__ __forceinline__ void operator()(const f32x4 (&acc)[2][2][4][2], const Unit& u, int wr, int wc, int fr, int fq) const {
        const int row0 = u.pm * BM + wr * 64 + fr; const int col0 = u.pn * BM + wc * 32 + 8 * fq;
#pragma unroll
        for (int ai = 0; ai < 2; ++ai)
#pragma unroll
            for (int m = 0; m < 4; ++m) { const int r = row0 + ai * HALF + m * 16;
#pragma unroll
                for (int bj = 0; bj < 2; ++bj) { const int c = col0 + bj * HALF; bf16_t* dst;
                    if (u.pm < 2) { const int part = r >> 8, ch = r & 255, b = c >> 12, s = c & 4095; dst = FT + ((size_t)((b * 256 + ch) * 2 + part)) * 4096 + s; }
                    else dst = VT + (size_t)(r - 512) * 32768 + c;
                    const f32x4 v0 = acc[ai][bj][m][0], v1 = acc[ai][bj][m][1];
                    u32x4 w; w.x = cvt_pk_bf16(v0[0], v0[1]); w.y = cvt_pk_bf16(v0[2], v0[3]); w.z = cvt_pk_bf16(v1[0], v1[1]); w.w = cvt_pk_bf16(v1[2], v1[3]);
                    *(u32x4*)dst = w; } }
    }
};

struct DftOrder {
    int c, G;
    __device__ __forceinline__ bool next(int i, Unit& u) const { const int d = c + i * G; if (d >= 128) return false; u.pm = d & 15; u.pn = d >> 4; return true; }
    __device__ __forceinline__ void a_ready(const Unit&) const {}
    __device__ __forceinline__ void done(const Unit&) const {}
};

template <class Epi, class Sched, bool ALIGN_EPI = false, bool SP2 = false>
__device__ __forceinline__ void gemm_phase(PG8_LAS unsigned char* lds, const Gemm g, const Sched& S, const Epi& E) {
    int tid_ = threadIdx.x; asm volatile("" : "+v"(tid_));
    const int tid = tid_, wid = __builtin_amdgcn_readfirstlane(tid >> 6), lane = tid & 63, wr = wid >> 2, wc = wid & 3, fr = lane & 15, fq = lane >> 4;
    const int K = g.K, nt = K / BK;
    unsigned voffA[2], voffB[2];
#pragma unroll
    for (int i = 0; i < 2; ++i) { int R, C; stage_rc(tid * 16 + i * 8192, R, C); const int Rb = Epi::PERM ? ((R & ~31) + perm32(R & 31)) : R;
        voffA[i] = (unsigned)(R * K + C) * 2u; voffB[i] = (unsigned)(Rb * K + C) * 2u; }
    const size_t kstep = (size_t)(BK * 2);
    const size_t hstep = (size_t)HALF * K * 2;
    const size_t tstep = 2 * hstep;
    const unsigned ldsw = (unsigned)wid * 1024u;
    const int aoff = lds_byte(wr * 64 + fr, fq * 8), boff = lds_byte(wc * 32 + fr, fq * 8);
#define PG8_SA(b, h) (((b) * 2 + (h)) * HTB)
#define PG8_SB(b, h) ((4 + (b) * 2 + (h)) * HTB)
#define PG8_STAGE(bufoff, gbase, voff) do { _Pragma("unroll") for (int _i = 0; _i < 2; ++_i) \
        __builtin_amdgcn_global_load_lds((const unsigned*)((const char*)(gbase) + (voff)[_i]), (PG8_LAS unsigned*)(lds + (bufoff) + ldsw + _i * 8192), 16, 0, 0); } while (0)
#define PG8_LDA(dst, b, h) do { _Pragma("unroll") for (int m = 0; m < 4; ++m) _Pragma("unroll") for (int k = 0; k < 2; ++k) dst[m][k] = *(const PG8_LAS bf16x8*)(lds + PG8_SA(b, h) + aoff + m * 2048 + k * 1024); } while (0)
#define PG8_LDB(dst, b, h) do { _Pragma("unroll") for (int n = 0; n < 2; ++n) _Pragma("unroll") for (int k = 0; k < 2; ++k) dst[n][k] = *(const PG8_LAS bf16x8*)(lds + PG8_SB(b, h) + boff + n * 2048 + k * 1024); } while (0)
#define PG8_MMA(ai, bj, At, Bt) do { __builtin_amdgcn_s_setprio(1); _Pragma("unroll") for (int m = 0; m < 4; ++m) _Pragma("unroll") for (int n = 0; n < 2; ++n) _Pragma("unroll") for (int k = 0; k < 2; ++k) \
        acc[ai][bj][m][n] = __builtin_amdgcn_mfma_f32_16x16x32_bf16(Bt[n][k], At[m][k], acc[ai][bj][m][n], 0, 0, 0); __builtin_amdgcn_s_setprio(0); } while (0)
#define PG8_WAIT_V(n) asm volatile("s_waitcnt vmcnt(" #n ")" ::: "memory")
#define PG8_WAIT_L(n) asm volatile("s_waitcnt lgkmcnt(" #n ")" ::: "memory")
#define PG8_BAR __builtin_amdgcn_s_barrier()
#define PG8_SCHED __builtin_amdgcn_sched_barrier(0)
    Unit cur, nxt; int ui = 0;
    if (!S.next(0, cur)) return;
    f32x4 acc[2][2][4][2];
#pragma unroll
    for (int a = 0; a < 2; ++a)
#pragma unroll
        for (int b = 0; b < 2; ++b)
#pragma unroll
            for (int m = 0; m < 4; ++m)
#pragma unroll
                for (int n = 0; n < 2; ++n) acc[a][b][m][n] = (f32x4){0.f, 0.f, 0.f, 0.f};
    bf16x8 At[4][2], B0[2][2], B1[2][2];
    const char* cA = (const char*)g.A + (size_t)cur.pm * tstep; const char* cB = (const char*)g.Bt + (size_t)cur.pn * tstep;
    S.a_ready(cur);
    if constexpr (SP2) {
        PG8_STAGE(PG8_SB(0, 0), cB, voffB); PG8_STAGE(PG8_SB(0, 1), cB + hstep, voffB); PG8_STAGE(PG8_SA(0, 0), cA, voffA); PG8_STAGE(PG8_SA(0, 1), cA + hstep, voffA);
        if (wr == 1) PG8_BAR;
        PG8_WAIT_V(2); PG8_BAR;
        PG8_STAGE(PG8_SB(1, 0), cB + kstep, voffB); PG8_STAGE(PG8_SA(1, 0), cA + kstep, voffA); PG8_STAGE(PG8_SB(1, 1), cB + hstep + kstep, voffB);
        PG8_WAIT_V(6); PG8_BAR;
    } else {
        PG8_STAGE(PG8_SB(0, 0), cB, voffB); PG8_STAGE(PG8_SA(0, 0), cA, voffA); PG8_STAGE(PG8_SB(0, 1), cB + hstep, voffB); PG8_STAGE(PG8_SA(0, 1), cA + hstep, voffA);
        if (wr == 1) PG8_BAR;
        PG8_WAIT_V(4); PG8_BAR;
        PG8_STAGE(PG8_SB(1, 0), cB + kstep, voffB); PG8_STAGE(PG8_SA(1, 0), cA + kstep, voffA); PG8_STAGE(PG8_SB(1, 1), cB + hstep + kstep, voffB);
        PG8_WAIT_V(6); PG8_BAR;
    }
    for (;;) {
        const bool has_next = S.next(ui + 1, nxt);
        const char* nA = has_next ? (const char*)g.A + (size_t)nxt.pm * tstep : cA; const char* nB = has_next ? (const char*)g.Bt + (size_t)nxt.pn * tstep : cB;
        for (int t = 0; t < nt; t += 2) {
            const bool last = (t == nt - 2);
            const char* a1 = cA + (size_t)(t + 1) * kstep;
            const char* a2 = last ? nA : cA + (size_t)(t + 2) * kstep; const char* b2 = last ? nB : cB + (size_t)(t + 2) * kstep;
            const char* a3 = a2 + kstep; const char* b3 = b2 + kstep;
            if (last && has_next) S.a_ready(nxt);
            if constexpr (SP2) {
            PG8_LDB(B0, 0, 0); PG8_LDB(B1, 0, 1); PG8_SCHED; PG8_LDA(At, 0, 0); PG8_STAGE(PG8_SA(1, 1), a1 + hstep, voffA);
            PG8_WAIT_V(8); PG8_WAIT_L(0); PG8_BAR; PG8_MMA(0, 0, At, B0); PG8_MMA(0, 1, At, B1); PG8_BAR; PG8_SCHED;
            PG8_LDA(At, 0, 1); PG8_STAGE(PG8_SB(0, 0), b2, voffB); PG8_STAGE(PG8_SB(0, 1), b2 + hstep, voffB); PG8_STAGE(PG8_SA(0, 0), a2, voffA);
            PG8_WAIT_V(8); PG8_WAIT_L(0); PG8_BAR; PG8_MMA(1, 0, At, B0); PG8_MMA(1, 1, At, B1); PG8_BAR; PG8_SCHED;
            PG8_LDB(B0, 1, 0); PG8_LDB(B1, 1, 1); PG8_SCHED; PG8_LDA(At, 1, 0); PG8_STAGE(PG8_SA(0, 1), a2 + hstep, voffA);
            PG8_WAIT_V(8); PG8_WAIT_L(0); PG8_BAR; PG8_MMA(0, 0, At, B0); PG8_MMA(0, 1, At, B1); PG8_BAR; PG8_SCHED;
            PG8_LDA(At, 1, 1); PG8_STAGE(PG8_SB(1, 0), b3, voffB); PG8_STAGE(PG8_SB(1, 1), b3 + hstep, voffB); PG8_STAGE(PG8_SA(1, 0), a3, voffA);
            PG8_WAIT_V(8); PG8_WAIT_L(0); PG8_BAR; PG8_MMA(1, 0, At, B0); PG8_MMA(1, 1, At, B1); PG8_BAR; PG8_SCHED;
            } else {
            PG8_LDB(B0, 0, 0); PG8_SCHED; PG8_LDA(At, 0, 0); PG8_STAGE(PG8_SA(1, 1), a1 + hstep, voffA);
            PG8_WAIT_L(8); PG8_BAR; PG8_WAIT_L(0); PG8_MMA(0, 0, At, B0); PG8_BAR; PG8_SCHED;
            PG8_LDB(B1, 0, 1); PG8_STAGE(PG8_SB(0, 0), b2, voffB);
            PG8_BAR; PG8_WAIT_L(0); PG8_MMA(0, 1, At, B1); PG8_BAR;
            PG8_LDA(At, 0, 1); PG8_STAGE(PG8_SA(0, 0), a2, voffA);
            PG8_BAR; PG8_WAIT_L(0); PG8_MMA(1, 0, At, B0); PG8_BAR; PG8_SCHED;
            PG8_STAGE(PG8_SB(0, 1), b2 + hstep, voffB);
            PG8_WAIT_V(6); PG8_BAR; PG8_MMA(1, 1, At, B1); PG8_BAR;
            PG8_LDB(B0, 1, 0); PG8_SCHED; PG8_LDA(At, 1, 0); PG8_STAGE(PG8_SA(0, 1), a2 + hstep, voffA);
            PG8_WAIT_L(8); PG8_BAR; PG8_WAIT_L(0); PG8_MMA(0, 0, At, B0); PG8_BAR; PG8_SCHED;
            PG8_LDB(B1, 1, 1); PG8_STAGE(PG8_SB(1, 0), b3, voffB);
            PG8_BAR; PG8_WAIT_L(0); PG8_MMA(0, 1, At, B1); PG8_BAR;
            PG8_LDA(At, 1, 1); PG8_STAGE(PG8_SA(1, 0), a3, voffA);
            PG8_BAR; PG8_WAIT_L(0); PG8_MMA(1, 0, At, B0); PG8_BAR; PG8_SCHED;
            PG8_STAGE(PG8_SB(1, 1), b3 + hstep, voffB);
            PG8_WAIT_V(6); PG8_BAR; PG8_MMA(1, 1, At, B1); PG8_BAR;
            }
        }
        if constexpr (ALIGN_EPI) { if (wr == 0) PG8_BAR; }
        if constexpr (!Epi::AFTER_DRAIN) { E(acc, cur, wr, wc, fr, fq); S.done(cur); }
        if (!has_next) break;
#pragma unroll
        for (int a = 0; a < 2; ++a)
#pragma unroll
            for (int b = 0; b < 2; ++b)
#pragma unroll
                for (int m = 0; m < 4; ++m)
#pragma unroll
                    for (int n = 0; n < 2; ++n) acc[a][b][m][n] = (f32x4){0.f, 0.f, 0.f, 0.f};
        cur = nxt; cA = nA; cB = nB; ++ui;
        if constexpr (ALIGN_EPI) { if (wr == 1) PG8_BAR; }
    }
    PG8_WAIT_V(0);
    if constexpr (!ALIGN_EPI) { if (wr == 0) PG8_BAR; }
    PG8_BAR;
    if constexpr (Epi::AFTER_DRAIN) { E.fused(acc, cur, wr, wc, fr, fq, lds, wid, lane); S.done(cur); }
#undef PG8_SA
#undef PG8_SB
#undef PG8_STAGE
#undef PG8_LDA
#undef PG8_LDB
#undef PG8_MMA
#undef PG8_WAIT_V
#undef PG8_WAIT_L
#undef PG8_BAR
#undef PG8_SCHED
}
}

#define LAS __attribute__((address_space(3)))
typedef unsigned short bf16_t;
typedef float f32x4 __attribute__((ext_vector_type(4)));
typedef float f32x16 __attribute__((ext_vector_type(16)));
typedef unsigned u32x4 __attribute__((ext_vector_type(4)));
typedef unsigned u32x2 __attribute__((ext_vector_type(2)));
typedef short bf16x8 __attribute__((ext_vector_type(8)));

constexpr int DM = 1024, NB = 8, SEQ = 4096, NTOK = NB * SEQ, DEPTH = 2, DFF = 2816, NGU = 2 * DFF, NIN = 2304, NQKP = 1280;
constexpr int NWAVES = 8, NTHREADS = 512;
constexpr size_t MiB = 1u << 20;
constexpr size_t WS_WGU = 0, WS_WD = 44 * MiB, WS_WIN = 66 * MiB, WS_WOUT = 75 * MiB, WS_DFT = 80 * MiB, WS_ADA = 144 * MiB, WS_ROPE = 145 * MiB, WS_SCAL = 146 * MiB,
                 WS_HY = 148 * MiB, WS_BIG = 212 * MiB, WS_QKP = WS_BIG, WS_VT = 292 * MiB, WS_FT = 324 * MiB, WS_MIX = 356 * MiB, WS_END = 420 * MiB;
constexpr int LDS_BYTES = 147456;

using pg8::cvt_pk_bf16;
__device__ __forceinline__ float bf2f(unsigned short b) { return __uint_as_float((unsigned)b << 16); }
__device__ __forceinline__ float wave_sum(float v) {
#pragma unroll
    for (int o = 1; o < 64; o <<= 1) v += __shfl_xor(v, o);
    return v;
}
#define LDS_WAIT() asm volatile("s_waitcnt lgkmcnt(0)" ::: "memory")

struct Args {
    const float* x; const float* c; const int* pos; const float* w_ada; const float* b_ada; const float* g_pre; const float* g_post;
    const float* w_gu; const float* w_down; const float* w_in; const float* w_f; const float* lq1; const float* lk1; const float* lq2; const float* lk2;
    const float* g_subln; const float* w_pool; const float* pool_scale; const float* w_out;
    float* out; unsigned char* ws; int ph_lo, ph_hi;
};

__device__ __forceinline__ void tr_item(const float* W, int ldw, int k0, int n0, bf16_t* WT, int ldt, int dbase, int dmul, float scale, LAS float* scr, int lane) {
#pragma unroll 8
    for (int i = 0; i < 32; ++i) { const int kk = 2 * i + (lane >> 5); scr[kk * 33 + (lane & 31)] = W[(size_t)(k0 + kk) * ldw + n0 + (lane & 31)]; }
    LDS_WAIT(); asm volatile("" ::: "memory");
    const int c = lane & 7;
#pragma unroll
    for (int j = 0; j < 4; ++j) { const int n = (lane >> 3) + 8 * j; const LAS float* s = scr + (8 * c) * 33 + n;
        u32x4 o; o.x = cvt_pk_bf16(s[0 * 33] * scale, s[1 * 33] * scale); o.y = cvt_pk_bf16(s[2 * 33] * scale, s[3 * 33] * scale);
        o.z = cvt_pk_bf16(s[4 * 33] * scale, s[5 * 33] * scale); o.w = cvt_pk_bf16(s[6 * 33] * scale, s[7 * 33] * scale);
        *(u32x4*)(WT + (size_t)(dbase + n * dmul) * ldt + k0 + 8 * c) = o; }
    LDS_WAIT(); asm volatile("" ::: "memory");
}

__device__ __forceinline__ void fold_apply(const float* Wsrc, int ncon, const LAS float* M, bf16_t* dst, int tid) {
#pragma unroll 1
    for (int i = 0; i < 2; ++i) { const int k = tid + 512 * i; float acc[16];
#pragma unroll
        for (int j = 0; j < 16; ++j) acc[j] = 0.f;
        const float* wr = Wsrc + (size_t)k * 2048;
#pragma unroll 1
        for (int hc = 0; hc < ncon; hc += 4) { const f32x4 w4 = *(const f32x4*)(wr + hc);
#pragma unroll
            for (int e = 0; e < 4; ++e) { const LAS f32x4* mp = (const LAS f32x4*)(M + (hc + e) * 16);
#pragma unroll
                for (int q = 0; q < 4; ++q) { const f32x4 mv = mp[q]; acc[4 * q] += w4[e] * mv[0]; acc[4 * q + 1] += w4[e] * mv[1]; acc[4 * q + 2] += w4[e] * mv[2]; acc[4 * q + 3] += w4[e] * mv[3]; } } }
#pragma unroll
        for (int j = 0; j < 16; ++j) dst[(size_t)j * 1024 + k] = (bf16_t)(cvt_pk_bf16(acc[j], 0.f) & 0xffffu); }
}

__device__ __forceinline__ void prologue(const Args& a, LAS unsigned char* lds, int G, int bid) {
    const int tid = threadIdx.x, lane = tid & 63, wave = __builtin_amdgcn_readfirstlane(tid >> 6);
    unsigned char* ws = a.ws;
    bf16_t* WGU = (bf16_t*)(ws + WS_WGU); bf16_t* WD = (bf16_t*)(ws + WS_WD); bf16_t* WIN = (bf16_t*)(ws + WS_WIN); bf16_t* WOUT = (bf16_t*)(ws + WS_WOUT);
    for (int it = bid; it < 384; it += G) {
        LAS float* Mf = (LAS float*)lds;
        if (it < 64) {
            const int l = it >> 5, part = (it >> 4) & 1, j0 = (it & 15) * 16;
            const float* wf = a.w_f + (size_t)l * 256 * 256;
#pragma unroll 1
            for (int i = 0; i < 8; ++i) { const int e = tid + 512 * i, hc = e >> 4, jj = e & 15, h = hc >> 6, cc = hc & 63; float s = 0.f;
#pragma unroll 4
                for (int cp = 0; cp < 64; ++cp) { const float rev = (float)((cc * cp) & 63) * (1.0f / 64.0f);
                    const float t = part ? __builtin_amdgcn_sinf(rev) : __builtin_amdgcn_cosf(rev);
                    s += t * wf[(size_t)(h * 64 + cp) * 256 + j0 + jj]; }
                Mf[hc * 16 + jj] = s * (1.0f / 512.0f); }
            __syncthreads();
            fold_apply(a.w_in + (size_t)l * 1024 * 2048, 256, Mf, WIN + ((size_t)l * NIN + 1280 + part * 256 + j0) * 1024, tid);
            __syncthreads();
        } else if (it < 96) {
            const int r = it - 64, l = r >> 4, g = (r >> 2) & 3, d0 = (r & 3) * 16;
            for (int e = tid; e < 1024; e += 512) { const int cc = e >> 4, dd = e & 15;
                Mf[e] = a.w_pool[(((size_t)l * 4 + g) * 64 + cc) * 64 + d0 + dd] * a.pool_scale[l * 256 + g * 64 + d0 + dd]; }
            __syncthreads();
            fold_apply(a.w_in + (size_t)l * 1024 * 2048 + 1792 + g * 64, 64, Mf, WIN + ((size_t)l * NIN + 1024 + g * 64 + d0) * 1024, tid);
            __syncthreads();
        } else {
            const int r = it - 96, l = r / 144, j0 = (r % 144) * 64;
            LAS float* cact = (LAS float*)lds;
            LAS float* red = (LAS float*)(lds + 32768);
            for (int e = tid; e < 8192; e += 512) { const float v = a.c[e]; cact[e] = v / (1.0f + __expf(-v)); }
            __syncthreads();
            const int col = tid & 63, kg = tid >> 6; float acc[8];
#pragma unroll
            for (int b = 0; b < 8; ++b) acc[b] = 0.f;
            const float* wp = a.w_ada + ((size_t)l * 1024 + kg * 128) * 9216 + j0 + col;
#pragma unroll 4
            for (int k = 0; k < 128; ++k) { const float w = wp[(size_t)k * 9216];
#pragma unroll
                for (int b = 0; b < 8; ++b) acc[b] += cact[b * 1024 + kg * 128 + k] * w; }
#pragma unroll
            for (int b = 0; b < 8; ++b) red[(kg * 8 + b) * 64 + col] = acc[b];
            __syncthreads();
            { const int b = tid >> 6; float s = 0.f;
#pragma unroll
              for (int q = 0; q < 8; ++q) s += red[(q * 8 + b) * 64 + col];
              ((float*)(ws + WS_ADA))[((size_t)l * 8 + b) * 9216 + j0 + col] = s + a.b_ada[(size_t)l * 9216 + j0 + col]; }
            __syncthreads();
        }
    }
    __syncthreads();
    {
        LAS float* scr = (LAS float*)(lds + wave * 16384);
        const int gw = bid * NWAVES + wave, NGW = G * NWAVES;
        constexpr int I_GU = 16 * 176, I_D = 44 * 32, I_IN = 16 * 48, I_O = 16 * 32;
        constexpr int NIT = 4 * I_GU + 4 * I_D + 2 * I_IN + 2 * I_O;
        for (int it = gw; it < NIT; it += NGW) {
            int r = it;
            if (r < 4 * I_GU) { const int mi = r / I_GU; r -= mi * I_GU; const int kb = r / 176, nb = r % 176, n0 = 32 * nb;
                const int j = n0 < DFF ? n0 : n0 - DFF; const int drow = j + 128 * (j / 128) + (n0 < DFF ? 0 : 128);
                tr_item(a.w_gu + (size_t)mi * 1024 * NGU, NGU, 64 * kb, n0, WGU + (size_t)mi * NGU * 1024, 1024, drow, 1, 1.f, scr, lane); continue; }
            r -= 4 * I_GU;
            if (r < 4 * I_D) { const int mi = r / I_D; r -= mi * I_D; const int kb = r / 32, nb = r % 32;
                tr_item(a.w_down + (size_t)mi * DFF * 1024, 1024, 64 * kb, 32 * nb, WD + (size_t)mi * 1024 * DFF, DFF, 32 * nb, 1, 1.f, scr, lane); continue; }
            r -= 4 * I_D;
            if (r < 2 * I_IN) { const int l = r / I_IN; r -= l * I_IN; const int kb = r / 48, nb = r % 48;
                int dbase, dmul; float sc = 1.f;
                if (nb < 32) { dbase = (nb >> 1) * 64 + (nb & 1); dmul = 2; if (nb < 16) sc = 0.125f * 1.4426950408889634f; }
                else { dbase = 1792 + 32 * (nb - 32); dmul = 1; }
                tr_item(a.w_in + (size_t)l * 1024 * 2048, 2048, 64 * kb, 256 + 32 * nb, WIN + (size_t)l * NIN * 1024, 1024, dbase, dmul, sc, scr, lane); continue; }
            r -= 2 * I_IN;
            { const int l = r / I_O; r -= l * I_O; const int kb = r / 32, nb = r % 32;
              tr_item(a.w_out + (size_t)l * 1024 * 1024, 1024, 64 * kb, 32 * nb, WOUT + (size_t)l * 1024 * 1024, 1024, 32 * nb, 1, 1.f, scr, lane); }
        }
    }
    {
        const size_t gt = (size_t)bid * NTHREADS + tid, NGT = (size_t)G * NTHREADS;
        bf16_t* DFT = (bf16_t*)(ws + WS_DFT);
        for (size_t e = gt; e < (size_t)4096 * 1024; e += NGT) { const int sp = (int)(e >> 10), k0 = (int)(e & 1023) * 8; float v[8];
#pragma unroll
            for (int j = 0; j < 8; ++j) { const int k = k0 + j; const float rev = (float)((sp * (k & 4095)) & 4095) * (1.0f / 4096.0f);
                v[j] = (k < 4096) ? __builtin_amdgcn_cosf(rev) : -__builtin_amdgcn_sinf(rev); }
            u32x4 o; o.x = cvt_pk_bf16(v[0], v[1]); o.y = cvt_pk_bf16(v[2], v[3]); o.z = cvt_pk_bf16(v[4], v[5]); o.w = cvt_pk_bf16(v[6], v[7]);
            *(u32x4*)(DFT + (size_t)sp * 8192 + k0) = o; }
        float* rope = (float*)(ws + WS_ROPE);
        for (size_t e = gt; e < (size_t)4096 * 32; e += NGT) { const int s = (int)(e >> 5), i = (int)(e & 31);
            const float inv = 1.0f / __builtin_exp2f((float)i * (13.287712379549449f / 32.0f));
            const float ang = (float)a.pos[s] * inv;
            const double rv = (double)ang * 0.15915494309189535; const double fr = rv - __builtin_rint(rv); const float f = (float)fr;
            rope[e * 2] = __builtin_amdgcn_cosf(f); rope[e * 2 + 1] = __builtin_amdgcn_sinf(f); }
        if (gt < 2) { const int l = (int)gt; float s1 = 0.f, s2 = 0.f;
            for (int i = 0; i < 64; ++i) { s1 += a.lq1[l * 64 + i] * a.lk1[l * 64 + i]; s2 += a.lq2[l * 64 + i] * a.lk2[l * 64 + i]; }
            const float li = 0.8f - 0.6f * __expf(-0.3f * (float)l);
            float* sc = (float*)(ws + WS_SCAL); sc[2 * l] = __expf(s1) - __expf(s2) + li; sc[2 * l + 1] = 1.0f - li; }
    }
}

template <bool HAS_Y, bool HAS_NORM>
__device__ __forceinline__ void thin_phase(const Args& a, const float* xsrc, int lpost, int sub_post, float wres, int lpre, int sub_pre, int G, int bid) {
    int tid_ = threadIdx.x; asm volatile("" : "+v"(tid_));
    const int tid = tid_, lane = tid & 63, wave = tid >> 6;
    const float* ada = (const float*)(a.ws + WS_ADA); bf16_t* HY = (bf16_t*)(a.ws + WS_HY);
    for (int rb = bid * NWAVES + wave; rb < NTOK / 16; rb += G * NWAVES) {
        const int row0 = rb * 16, b = row0 >> 12;
        f32x4 cg_[4], gs[4], sh[4];
#pragma unroll
        for (int j = 0; j < 4; ++j) { const int col = 4 * (lane + 64 * j);
            if (HAS_Y) { const f32x4 gate = *(const f32x4*)(ada + ((size_t)(lpost * 8 + b) * 9 + sub_post * 3 + 2) * 1024 + col);
                const f32x4 gp = *(const f32x4*)(a.g_post + (size_t)(lpost * 3 + sub_post) * 1024 + col); cg_[j] = gate * gp * wres; }
            if (HAS_NORM) { const f32x4 gpre = *(const f32x4*)(a.g_pre + (size_t)(lpre * 3 + sub_pre) * 1024 + col);
                const f32x4 scl = *(const f32x4*)(ada + ((size_t)(lpre * 8 + b) * 9 + sub_pre * 3 + 1) * 1024 + col);
                sh[j] = *(const f32x4*)(ada + ((size_t)(lpre * 8 + b) * 9 + sub_pre * 3 + 0) * 1024 + col); gs[j] = gpre * (scl + 1.0f); } }
#pragma unroll 2
        for (int rr = 0; rr < 16; ++rr) { const size_t ro = (size_t)(row0 + rr) * 1024;
            f32x4 x[4];
#pragma unroll
            for (int j = 0; j < 4; ++j) x[j] = *(const f32x4*)(xsrc + ro + 4 * (lane + 64 * j));
            if (HAS_Y) { f32x4 y[4]; float ss = 0.f;
#pragma unroll
                for (int j = 0; j < 4; ++j) { const u32x2 yw = *(const u32x2*)(HY + ro + 4 * (lane + 64 * j));
                    y[j][0] = __uint_as_float(yw.x << 16); y[j][1] = __uint_as_float(yw.x & 0xffff0000u); y[j][2] = __uint_as_float(yw.y << 16); y[j][3] = __uint_as_float(yw.y & 0xffff0000u);
                    ss += (y[j][0] * y[j][0] + y[j][1] * y[j][1]) + (y[j][2] * y[j][2] + y[j][3] * y[j][3]); }
                const float rstd = 1.0f / sqrtf(wave_sum(ss) * (1.0f / 1024.0f) + 1e-6f);
#pragma unroll
                for (int j = 0; j < 4; ++j) { x[j] = x[j] + cg_[j] * y[j] * rstd; *(f32x4*)(a.out + ro + 4 * (lane + 64 * j)) = x[j]; } }
            if (HAS_NORM) { float ss = 0.f;
#pragma unroll
                for (int j = 0; j < 4; ++j) ss += (x[j][0] * x[j][0] + x[j][1] * x[j][1]) + (x[j][2] * x[j][2] + x[j][3] * x[j][3]);
                const float rstd = 1.0f / sqrtf(wave_sum(ss) * (1.0f / 1024.0f) + 1e-6f);
#pragma unroll
                for (int j = 0; j < 4; ++j) { const f32x4 hv = x[j] * rstd * gs[j] + sh[j]; u32x2 w; w.x = cvt_pk_bf16(hv[0], hv[1]); w.y = cvt_pk_bf16(hv[2], hv[3]);
                    *(u32x2*)(HY + ro + 4 * (lane + 64 * j)) = w; } }
        }
    }
}

namespace att {
constexpr int ROWB = 144, KBY = 64 * ROWB, STAGE = 2 * KBY + 128 * ROWB;
#define MFMA32(a_, b_, c_) __builtin_amdgcn_mfma_f32_32x32x16_bf16((a_), (b_), (c_), 0, 0, 0)
__device__ __forceinline__ float swapmax(float m) { auto rr = __builtin_amdgcn_permlane32_swap(__float_as_uint(m), __float_as_uint(m), false, false); return __builtin_fmaxf(__uint_as_float(rr[0]), __uint_as_float(rr[1])); }
__device__ __forceinline__ float swapsum(float m) { auto rr = __builtin_amdgcn_permlane32_swap(__float_as_uint(m), __float_as_uint(m), false, false); return __uint_as_float(rr[0]) + __uint_as_float(rr[1]); }
__device__ __forceinline__ bf16x8 pack8(const f32x16& p, int s) { u32x4 w; w.x = cvt_pk_bf16(p[8 * s], p[8 * s + 1]); w.y = cvt_pk_bf16(p[8 * s + 2], p[8 * s + 3]); w.z = cvt_pk_bf16(p[8 * s + 4], p[8 * s + 5]); w.w = cvt_pk_bf16(p[8 * s + 6], p[8 * s + 7]); return __builtin_bit_cast(bf16x8, w); }

__device__ __forceinline__ void attn_unit(LAS unsigned char* lds, const bf16_t* QKP, const bf16_t* VT, bf16_t* MIX, int b, int h, int qb, float lam, float oml, const float* gsub) {
    int tid_ = threadIdx.x; asm volatile("" : "+v"(tid_));
    const int tid = tid_, lane = tid & 63, wid = __builtin_amdgcn_readfirstlane(tid >> 6), r32 = lane & 31, hi = lane >> 5, map = wid >> 2, rg = wid & 3;
    const size_t tok0 = (size_t)b * SEQ;
    const int lkey = tid >> 3, lch = tid & 7;
    const bf16_t* kg0 = QKP + (tok0 + lkey) * NQKP + 512 + (2 * h) * 64 + lch * 8;
    const bf16_t* vg0 = VT + (size_t)(h * 128 + lkey) * NTOK + tok0 + lch * 8;
    const int lk_off = lkey * ROWB + lch * 16, lv_off = 2 * KBY + lkey * ROWB + lch * 16;
    u32x4 kr0, kr1, vr0, vr1;
#define ATT_LOAD(t) do { kr0 = *(const u32x4*)(kg0 + (size_t)(t) * 64 * NQKP); kr1 = *(const u32x4*)(kg0 + (size_t)(t) * 64 * NQKP + 64); \
                         vr0 = *(const u32x4*)(vg0 + (t) * 64); vr1 = *(const u32x4*)(vg0 + (size_t)64 * NTOK + (t) * 64); } while (0)
#define ATT_STORE(st) do { LAS unsigned char* sb_ = lds + (st) * STAGE; *(LAS u32x4*)(sb_ + lk_off) = kr0; *(LAS u32x4*)(sb_ + KBY + lk_off) = kr1; \
                           *(LAS u32x4*)(sb_ + lv_off) = vr0; *(LAS u32x4*)(sb_ + lv_off + 64 * ROWB) = vr1; } while (0)
    ATT_LOAD(0);
    const bf16_t* qg = QKP + (tok0 + qb * 128 + rg * 32 + r32) * NQKP + (2 * h + map) * 64 + hi * 8;
    bf16x8 qr[4];
#pragma unroll
    for (int d0 = 0; d0 < 4; ++d0) qr[d0] = *(const bf16x8*)(qg + d0 * 16);
    const int m16 = r32 & 15, g4 = m16 >> 2, g4p = (g4 == 1) ? 2 : (g4 == 2) ? 1 : g4, prow = (r32 & 16) | (g4p << 2) | (r32 & 3);
    const int kfa = map * KBY + prow * ROWB + hi * 16, vfa = 2 * KBY + r32 * ROWB + hi * 16;
    f32x16 o[4];
#pragma unroll
    for (int v = 0; v < 4; ++v)
#pragma unroll
        for (int r = 0; r < 16; ++r) o[v][r] = 0.f;
    float mhat = 0.f, lsum = 0.f;
    ATT_STORE(0);
    __syncthreads();
#pragma unroll 1
    for (int t = 0; t < 64; ++t) {
        const int st = t & 1;
        if (t + 1 < 64) ATT_LOAD(t + 1);
        const LAS unsigned char* sb = lds + st * STAGE;
        f32x16 p0, p1;
#pragma unroll
        for (int r = 0; r < 16; ++r) { p0[r] = -mhat; p1[r] = -mhat; }
#pragma unroll
        for (int d0 = 0; d0 < 4; ++d0) { const bf16x8 k0 = *(const LAS bf16x8*)(sb + kfa + d0 * 32), k1 = *(const LAS bf16x8*)(sb + kfa + 32 * ROWB + d0 * 32);
            p0 = MFMA32(k0, qr[d0], p0); p1 = MFMA32(k1, qr[d0], p1); }
        float rm = __builtin_fmaxf(p0[0], p1[0]);
#pragma unroll
        for (int r = 1; r < 16; ++r) rm = __builtin_fmaxf(rm, __builtin_fmaxf(p0[r], p1[r]));
        rm = swapmax(rm);
        const bool first = (t == 0);
        if (first || __any(rm > 8.0f)) {
            const float dl = first ? rm : __builtin_fmaxf(rm, 0.f); mhat += dl;
#pragma unroll
            for (int r = 0; r < 16; ++r) { p0[r] -= dl; p1[r] -= dl; }
            if (!first) { const float al = __builtin_amdgcn_exp2f(-dl); lsum *= al;
#pragma unroll
                for (int v = 0; v < 4; ++v)
#pragma unroll
                    for (int r = 0; r < 16; ++r) o[v][r] *= al; }
        }
        float sacc = 0.f;
#pragma unroll
        for (int r = 0; r < 16; ++r) { p0[r] = __builtin_amdgcn_exp2f(p0[r]); p1[r] = __builtin_amdgcn_exp2f(p1[r]); sacc += p0[r] + p1[r]; }
        lsum += sacc;
        bf16x8 pf[4]; pf[0] = pack8(p0, 0); pf[1] = pack8(p0, 1); pf[2] = pack8(p1, 0); pf[3] = pack8(p1, 1);
#pragma unroll
        for (int v = 0; v < 4; ++v)
#pragma unroll
            for (int ks = 0; ks < 4; ++ks) { const bf16x8 vf = *(const LAS bf16x8*)(sb + vfa + v * 32 * ROWB + ks * 32); o[v] = MFMA32(vf, pf[ks], o[v]); }
        if (t + 1 < 64) ATT_STORE(st ^ 1);
        __syncthreads();
    }
#undef ATT_LOAD
#undef ATT_STORE
    const float inv = 1.0f / swapsum(lsum);
#pragma unroll
    for (int v = 0; v < 4; ++v)
#pragma unroll
        for (int r = 0; r < 16; ++r) o[v][r] *= inv;
    LAS float* cmb = (LAS float*)lds;
    if (map == 1) {
#pragma unroll
        for (int v = 0; v < 4; ++v)
#pragma unroll
            for (int r = 0; r < 16; ++r) cmb[(rg * 64 + v * 16 + r) * 64 + lane] = o[v][r];
    }
    __syncthreads();
    if (map == 0) {
        float ss = 0.f;
#pragma unroll
        for (int v = 0; v < 4; ++v)
#pragma unroll
            for (int r = 0; r < 16; ++r) { const float d = o[v][r] - lam * cmb[(rg * 64 + v * 16 + r) * 64 + lane]; o[v][r] = d; ss += d * d; }
        ss = swapsum(ss);
        const float rstd = oml / sqrtf(ss * (1.0f / 128.0f) + 1e-5f);
        bf16_t* op = MIX + (tok0 + qb * 128 + rg * 32 + r32) * 1024 + 256 + h * 128;
#pragma unroll
        for (int v = 0; v < 4; ++v)
#pragma unroll
            for (int q = 0; q < 4; ++q) { const int vc = 32 * v + 8 * q + 4 * hi; const f32x4 g = *(const f32x4*)(gsub + vc);
                u32x2 w; w.x = cvt_pk_bf16(o[v][4 * q] * rstd * g[0], o[v][4 * q + 1] * rstd * g[1]); w.y = cvt_pk_bf16(o[v][4 * q + 2] * rstd * g[2], o[v][4 * q + 3] * rstd * g[3]);
                *(u32x2*)(op + vc) = w; }
    }
    __syncthreads();
}
}

__device__ __forceinline__ void pool_item(const bf16_t* QKP, bf16_t* MIX, int item) {
    const int tid = threadIdx.x, c = tid & 255, half = tid >> 8, b = item >> 6, s0 = (item & 63) * 64 + half * 32;
    const int hf = 1 << (c >> 6);
    const bf16_t* zp = QKP + ((size_t)b * SEQ) * NQKP + 1024 + c;
    for (int s = s0; s < s0 + 32; ++s) { const int lo = s - hf < 0 ? 0 : s - hf, hi = s + hf > SEQ ? SEQ : s + hf; float sum = 0.f;
        for (int j = lo; j < hi; ++j) sum += bf2f(zp[(size_t)j * NQKP]);
        const float v = sum / (float)(hi - lo) - bf2f(zp[(size_t)s * NQKP]);
        MIX[((size_t)b * SEQ + s) * 1024 + 768 + c] = (bf16_t)(cvt_pk_bf16(v, 0.f) & 0xffffu); }
}

#ifndef NO_ATT
#define ATTN_CALL(u) att::attn_unit(lds, QKP, VT, MIX, (u) >> 7, ((u) >> 5) & 3, (u) & 31, lam, oml, gsub)
#else
#define ATTN_CALL(u) (void)0
#endif
#ifdef NO_GEMM
#define GEMM_PHASE(...) (void)0
#else
#define GEMM_PHASE(...) pg8::gemm_phase<__VA_ARGS__>
#endif
typedef const __attribute__((address_space(4))) Args* CArgsP;
#if defined(__HIP_DEVICE_COMPILE__)
__device__ __forceinline__ Args load_args() { CArgsP p = (CArgsP)__builtin_amdgcn_kernarg_segment_ptr(); asm volatile("" : "+s"(p)); return *p; }
#else
__device__ __forceinline__ Args load_args() { return Args{}; }
#endif
__global__ void __launch_bounds__(NTHREADS, 2) fwd_kernel(Args a_in) {
    extern __shared__ __attribute__((aligned(16))) unsigned char lds_raw[];
    LAS unsigned char* lds = (LAS unsigned char*)lds_raw;
    const int G0 = gridDim.x, bid0 = blockIdx.x;
    const int lo = a_in.ph_lo, hi = a_in.ph_hi;
    int ph = 0; int l0 = 0, f0 = 0;
#define PHASE_BEGIN if (ph >= lo && ph < hi) { const Args a = load_args(); unsigned char* ws = a.ws; int G = G0, bid = bid0, l = l0, f = f0; asm volatile("" : "+s"(G), "+s"(bid), "+s"(l), "+s"(f)); \
    const int vcu = (G % 8 == 0) ? (bid % 8) * (G / 8) + bid / 8 : bid; (void)vcu; (void)l; (void)f; \
    bf16_t* WGU = (bf16_t*)(ws + WS_WGU); bf16_t* WD = (bf16_t*)(ws + WS_WD); bf16_t* WIN = (bf16_t*)(ws + WS_WIN); bf16_t* WOUT = (bf16_t*)(ws + WS_WOUT); \
    bf16_t* DFT = (bf16_t*)(ws + WS_DFT); bf16_t* HY = (bf16_t*)(ws + WS_HY); bf16_t* HID = (bf16_t*)(ws + WS_BIG); \
    bf16_t* QKP = (bf16_t*)(ws + WS_QKP); bf16_t* VT = (bf16_t*)(ws + WS_VT); bf16_t* FT = (bf16_t*)(ws + WS_FT); bf16_t* MIX = (bf16_t*)(ws + WS_MIX); \
    const float* rope = (const float*)(ws + WS_ROPE); const float* scal = (const float*)(ws + WS_SCAL); \
    (void)WGU; (void)WD; (void)WIN; (void)WOUT; (void)DFT; (void)HY; (void)HID; (void)QKP; (void)VT; (void)FT; (void)MIX; (void)rope; (void)scal;
#define PHASE_END   if (ph + 1 < hi) cg::this_grid().sync(); } ++ph;

#ifndef NO_PRO
    PHASE_BEGIN prologue(a, lds, G, bid); PHASE_END
#endif
    PHASE_BEGIN thin_phase<false, true>(a, a.x, 0, 0, 0.f, 0, 0, G, bid); PHASE_END
#pragma unroll 1
    for (l0 = 0; l0 < DEPTH; ++l0) {
#pragma unroll 1
        for (f0 = 0; f0 < 2; ++f0) {
            if (f0 == 1) {
                PHASE_BEGIN
                { pg8::Gemm g{HY, WIN + (size_t)l * NIN * 1024, NTOK, NQKP, 1024}; pg8::StaticOrder S; S.init(NTOK, NQKP, G, bid); pg8::EpiRope E{QKP, rope};
                  GEMM_PHASE(pg8::EpiRope, pg8::StaticOrder, true, true)(lds, g, S, E); }
                { pg8::Gemm g{WIN + ((size_t)l * NIN + 1280) * 1024, HY, 1024, NTOK, 1024}; pg8::StaticOrder S; S.init(1024, NTOK, G, bid); pg8::EpiChanMajor E{FT, VT};
                  GEMM_PHASE(pg8::EpiChanMajor, pg8::StaticOrder, true, true)(lds, g, S, E); }
                PHASE_END
                PHASE_BEGIN
                for (int it = vcu; it < 512; it += G) pool_item(QKP, MIX, it);
                __syncthreads();
                const int xc = vcu >> 5, jl = vcu & 31;
                { pg8::Gemm g{DFT, FT, SEQ, NB * 256, 2 * SEQ}; pg8::DftOrder S; S.G = G; S.c = (G == 256) ? (jl < 16 ? xc * 16 + jl : 128) : bid;
                  pg8::EpiBf16 E{MIX, 1024, 256, (size_t)SEQ * 1024};
                  GEMM_PHASE(pg8::EpiBf16, pg8::DftOrder, true, true)(lds, g, S, E); }
                __syncthreads();
                { const float lam = scal[2 * l], oml = scal[2 * l + 1]; const float* gsub = a.g_subln + l * 128;
                  if (G == 256) { const int u0 = jl < 16 ? 3 * jl : 48 + 5 * (jl - 16), nu = jl < 16 ? 3 : 5;
                      for (int i = 0; i < nu; ++i) { const int u = xc * 128 + u0 + i; ATTN_CALL(u); } }
                  else for (int u = bid; u < 1024; u += G) ATTN_CALL(u); }
                PHASE_END
                PHASE_BEGIN
                { pg8::Gemm g{MIX, WOUT + (size_t)l * 1024 * 1024, NTOK, 1024, 1024}; pg8::StaticOrder S; S.init(NTOK, 1024, G, bid); pg8::EpiBf16 E{HY, 1024, 0, 0};
                  GEMM_PHASE(pg8::EpiBf16, pg8::StaticOrder, true, true)(lds, g, S, E); }
                PHASE_END
                PHASE_BEGIN thin_phase<true, true>(a, a.out, l, 1, 1.0f, l, 2, G, bid); PHASE_END
            }
            PHASE_BEGIN
            { pg8::Gemm g{HY, WGU + (size_t)(l * 2 + f) * NGU * 1024, NTOK, NGU, 1024}; pg8::StaticOrder S; S.init(NTOK, NGU, G, bid); pg8::EpiSwiglu E{HID, DFF};
              GEMM_PHASE(pg8::EpiSwiglu, pg8::StaticOrder, true, true)(lds, g, S, E); }
            PHASE_END
            PHASE_BEGIN
            { pg8::Gemm g{HID, WD + (size_t)(l * 2 + f) * 1024 * DFF, NTOK, 1024, DFF}; pg8::StaticOrder S; S.init(NTOK, 1024, G, bid); pg8::EpiBf16 E{HY, 1024, 0, 0};
              GEMM_PHASE(pg8::EpiBf16, pg8::StaticOrder, true, true)(lds, g, S, E); }
            PHASE_END
            if (f0 == 0) { PHASE_BEGIN thin_phase<true, true>(a, (l == 0) ? a.x : a.out, l, 0, 0.5f, l, 1, G, bid); PHASE_END }
            else if (l0 + 1 < DEPTH) { PHASE_BEGIN thin_phase<true, true>(a, a.out, l, 2, 0.5f, l + 1, 0, G, bid); PHASE_END }
            else { PHASE_BEGIN thin_phase<true, false>(a, a.out, l, 2, 0.5f, 0, 0, G, bid); PHASE_END }
        }
    }
#undef PHASE_BEGIN
#undef PHASE_END
}

constexpr int N_PHASES = 2 + DEPTH * 10;

extern "C" void kernel_launch(void* const* d_in, const int* in_sizes, int n_in, void* d_out, int out_size, void* d_ws, size_t ws_size, hipStream_t stream) {
    static int grid = 0;
    if (grid == 0) {
        if (n_in != 19 || ws_size < WS_END) { fprintf(stderr, "kernel_launch: unexpected inputs (n_in %d, ws %zu)\n", n_in, ws_size); grid = -1; return; }
        int dev = 0, cus = 0, per_cu = 0;
        hipGetDevice(&dev); hipDeviceGetAttribute(&cus, hipDeviceAttributeMultiprocessorCount, dev);
        if (hipFuncSetAttribute((const void*)fwd_kernel, hipFuncAttributeMaxDynamicSharedMemorySize, LDS_BYTES) != hipSuccess) { fprintf(stderr, "kernel_launch: hipFuncSetAttribute failed\n"); grid = -1; return; }
        if (hipOccupancyMaxActiveBlocksPerMultiprocessor(&per_cu, (const void*)fwd_kernel, NTHREADS, LDS_BYTES) != hipSuccess || per_cu < 1) { fprintf(stderr, "kernel_launch: occupancy query says %d\n", per_cu); per_cu = 1; }
        (void)hipGetLastError();
        grid = cus * 1;
        fprintf(stderr, "kernel_launch: grid %d (cus %d, per_cu %d)\n", grid, cus, per_cu);
    }
    if (grid < 0) return;
    Args a{};
    a.x = (const float*)d_in[0]; a.c = (const float*)d_in[1]; a.pos = (const int*)d_in[2]; a.w_ada = (const float*)d_in[3]; a.b_ada = (const float*)d_in[4];
    a.g_pre = (const float*)d_in[5]; a.g_post = (const float*)d_in[6]; a.w_gu = (const float*)d_in[7]; a.w_down = (const float*)d_in[8]; a.w_in = (const float*)d_in[9];
    a.w_f = (const float*)d_in[10]; a.lq1 = (const float*)d_in[11]; a.lk1 = (const float*)d_in[12]; a.lq2 = (const float*)d_in[13]; a.lk2 = (const float*)d_in[14];
    a.g_subln = (const float*)d_in[15]; a.w_pool = (const float*)d_in[16]; a.pool_scale = (const float*)d_in[17]; a.w_out = (const float*)d_in[18];
    a.out = (float*)d_out; a.ws = (unsigned char*)d_ws; a.ph_lo = 0; a.ph_hi = N_PHASES;
    void* args[] = {&a};
    hipError_t e = hipLaunchCooperativeKernel((const void*)fwd_kernel, dim3(grid), dim3(NTHREADS), args, LDS_BYTES, stream);
    if (e != hipSuccess) fprintf(stderr, "kernel_launch: cooperative launch failed: %s (grid %d)\n", hipGetErrorString(e), grid);
}
```

```cpp
#include <hip/hip_runtime.h>
#include <hip/hip_cooperative_groups.h>
#include <cstdio>
#include <cstdint>
namespace cg = cooperative_groups;
namespace pg8 {
#define PG8_LAS __attribute__((address_space(3)))
typedef unsigned short bf16_t;
typedef short bf16x8 __attribute__((ext_vector_type(8)));
typedef float f32x4 __attribute__((ext_vector_type(4)));
typedef unsigned u32x4 __attribute__((ext_vector_type(4)));
constexpr int BM = 256, BK = 64, HALF = 128, HTB = HALF * BK * 2  , STAGE_BYTES = 8 * HTB, NXCD = 8, WGM = 8;

__host__ __device__ __forceinline__ int lds_byte(int r, int c) { const int st = (r >> 4) * 2 + (c >> 5), rr = r & 15, cc = c & 31, ob = rr * 64 + cc * 2; return st * 1024 + (ob ^ (((ob >> 9) & 1) << 5)); }
__host__ __device__ __forceinline__ void stage_rc(int b, int& R, int& C) { const int st = b / 1024, sb = b % 1024, swz = sb ^ (((sb >> 9) & 1) << 5); R = (st >> 1) * 16 + swz / 64; C = (st & 1) * 32 + (swz % 64) / 2; }
__host__ __device__ __forceinline__ int perm32(int rho) { const int n = rho >> 4, i = rho & 15; return 8 * (i >> 2) + 4 * n + (i & 3); }

struct Unit { int pm, pn; };
struct Gemm { const bf16_t* A; const bf16_t* Bt; int M, N, K; };

struct StaticOrder {
    int nM, nN, nwg, G, c;
    __host__ __device__ void init(int M, int N, int G_, int c_) { nM = M / BM; nN = N / BM; nwg = nM * nN; G = G_; c = c_; }
    __host__ __device__ bool next(int i, Unit& u) const {
        const long L = (long)i * G + c; if (L >= nwg) return false;
        int wgid = (int)L; { const int q = nwg / NXCD, r = nwg % NXCD, xcd = wgid % NXCD, off = wgid / NXCD; wgid = (xcd < r ? xcd * (q + 1) : r * (q + 1) + (xcd - r) * q) + off; }
        const int nig = WGM * nN, gid = wgid / nig, fm = gid * WGM, gsz = (nM - fm) < WGM ? (nM - fm) : WGM;
        u.pm = fm + ((wgid % nig) % gsz); u.pn = (wgid % nig) / gsz; return true;
    }
    __device__ __forceinline__ void a_ready(const Unit&) const {}
    __device__ __forceinline__ void done(const Unit&) const {}
};


typedef float f32x2 __attribute__((ext_vector_type(2)));
typedef __bf16 bf16x2v __attribute__((ext_vector_type(2)));
__device__ __forceinline__ unsigned cvt_pk_bf16(float lo, float hi) { f32x2 v = {lo, hi}; bf16x2v b = __builtin_convertvector(v, bf16x2v); return __builtin_bit_cast(unsigned, b); }

struct EpiBf16 {
    static constexpr bool PERM = true, AFTER_DRAIN = false;
    bf16_t* O; int ldc; int split_cols; size_t split_stride;
    __device__ __forceinline__ void operator()(const f32x4 (&acc)[2][2][4][2], const Unit& u, int wr, int wc, int fr, int fq) const {
        const int row0 = u.pm * BM + wr * 64 + fr; int colt = u.pn * BM; bf16_t* base = O;
        if (split_cols) { const int t = colt / split_cols; base += (size_t)t * split_stride; colt -= t * split_cols; }
        const int col0 = colt + wc * 32 + 8 * fq;
#pragma unroll
        for (int ai = 0; ai < 2; ++ai)
#pragma unroll
            for (int m = 0; m < 4; ++m) { bf16_t* rowp = base + (size_t)(row0 + ai * HALF + m * 16) * ldc + col0;
#pragma unroll
                for (int bj = 0; bj < 2; ++bj) { const f32x4 v0 = acc[ai][bj][m][0], v1 = acc[ai][bj][m][1];
                    u32x4 w; w.x = cvt_pk_bf16(v0[0], v0[1]); w.y = cvt_pk_bf16(v0[2], v0[3]); w.z = cvt_pk_bf16(v1[0], v1[1]); w.w = cvt_pk_bf16(v1[2], v1[3]);
                    *(u32x4*)(rowp + bj * HALF) = w; } }
    }
};

struct EpiSwiglu {
    static constexpr bool PERM = true, AFTER_DRAIN = false;
    bf16_t* O; int ldc;
    __device__ __forceinline__ void operator()(const f32x4 (&acc)[2][2][4][2], const Unit& u, int wr, int wc, int fr, int fq) const {
        const int row0 = u.pm * BM + wr * 64 + fr; const int col0 = u.pn * HALF + wc * 32 + 8 * fq;
#pragma unroll
        for (int ai = 0; ai < 2; ++ai)
#pragma unroll
            for (int m = 0; m < 4; ++m) { bf16_t* rowp = O + (size_t)(row0 + ai * HALF + m * 16) * ldc + col0;
                float h[8];
#pragma unroll
                for (int n = 0; n < 2; ++n)
#pragma unroll
                    for (int j = 0; j < 4; ++j) { const float g = acc[ai][0][m][n][j], up = acc[ai][1][m][n][j];
                        const float e = __builtin_amdgcn_exp2f(-1.4426950408889634f * g); h[n * 4 + j] = g * up * __builtin_amdgcn_rcpf(1.0f + e); }
                u32x4 w; w.x = cvt_pk_bf16(h[0], h[1]); w.y = cvt_pk_bf16(h[2], h[3]); w.z = cvt_pk_bf16(h[4], h[5]); w.w = cvt_pk_bf16(h[6], h[7]);
                *(u32x4*)rowp = w; }
    }
};

struct EpiRope {
    static constexpr bool PERM = true, AFTER_DRAIN = false;
    bf16_t* O; const float* rope;
    __device__ __forceinline__ void operator()(const f32x4 (&acc)[2][2][4][2], const Unit& u, int wr, int wc, int fr, int fq) const {
        const int row0 = u.pm * BM + wr * 64 + fr; const int col0 = u.pn * BM + wc * 32 + 8 * fq; const bool rot = u.pn < 4;
#pragma unroll
        for (int ai = 0; ai < 2; ++ai)
#pragma unroll
            for (int m = 0; m < 4; ++m) { const int row = row0 + ai * HALF + m * 16; bf16_t* rowp = O + (size_t)row * 1280 + col0; const int s = row & 4095;
#pragma unroll
                for (int bj = 0; bj < 2; ++bj) { f32x4 v0 = acc[ai][bj][m][0], v1 = acc[ai][bj][m][1];
                    if (rot) { const int i0 = ((col0 + bj * HALF) & 63) >> 1; const f32x4* rp = (const f32x4*)(rope + ((size_t)s * 32 + i0) * 2);
                        const f32x4 c0 = rp[0], c1 = rp[1];
                        f32x4 o0, o1;
                        o0[0] = v0[0] * c0[0] - v0[1] * c0[1]; o0[1] = v0[1] * c0[0] + v0[0] * c0[1];
                        o0[2] = v0[2] * c0[2] - v0[3] * c0[3]; o0[3] = v0[3] * c0[2] + v0[2] * c0[3];
                        o1[0] = v1[0] * c1[0] - v1[1] * c1[1]; o1[1] = v1[1] * c1[0] + v1[0] * c1[1];
                        o1[2] = v1[2] * c1[2] - v1[3] * c1[3]; o1[3] = v1[3] * c1[2] + v1[2] * c1[3];
                        v0 = o0; v1 = o1; }
                    u32x4 w; w.x = cvt_pk_bf16(v0[0], v0[1]); w.y = cvt_pk_bf16(v0[2], v0[3]); w.z = cvt_pk_bf16(v1[0], v1[1]); w.w = cvt_pk_bf16(v1[2], v1[3]);
                    *(u32x4*)(rowp + bj * HALF) = w; } }
    }
};

struct EpiChanMajor {
    static constexpr bool PERM = true, AFTER_DRAIN = false;
    bf16_t* FT; bf16_t* VT;
    __device__ __forceinline__ void operator()(const f32x4 (&acc)[2][2][4][2], const Unit& u, int wr, int wc, int fr, int fq) const {
        const int row0 = u.pm * BM + wr * 64 + fr; const int col0 = u.pn * BM + wc * 32 + 8 * fq;
#pragma unroll
        for (int ai = 0; ai < 2; ++ai)
#pragma unroll
            for (int m = 0; m < 4; ++m) { const int r = row0 + ai * HALF + m * 16;
#pragma unroll
                for (int bj = 0; bj < 2; ++bj) { const int c = col0 + bj * HALF; bf16_t* dst;
                    if (u.pm < 2) { const int part = r >> 8, ch = r & 255, b = c >> 12, s = c & 4095; dst = FT + ((size_t)((b * 256 + ch) * 2 + part)) * 4096 + s; }
                    else dst = VT + (size_t)(r - 512) * 32768 + c;
                    const f32x4 v0 = acc[ai][bj][m][0], v1 = acc[ai][bj][m][1];
                    u32x4 w; w.x = cvt_pk_bf16(v0[0], v0[1]); w.y = cvt_pk_bf16(v0[2], v0[3]); w.z = cvt_pk_bf16(v1[0], v1[1]); w.w = cvt_pk_bf16(v1[2], v1[3]);
                    *(u32x4*)dst = w; } }
    }
};

struct DftOrder {
    int c, G;
    __device__ __forceinline__ bool next(int i, Unit& u) const { const int d = c + i * G; if (d >= 128) return false; u.pm = d & 15; u.pn = d >> 4; return true; }
    __device__ __forceinline__ void a_ready(const Unit&) const {}
    __device__ __forceinline__ void done(const Unit&) const {}
};

template <class Epi, class Sched, bool ALIGN_EPI = false, bool SP2 = false>
__device__ __forceinline__ void gemm_phase(PG8_LAS unsigned char* lds, const Gemm g, const Sched& S, const Epi& E) {
    int tid_ = threadIdx.x; asm volatile("" : "+v"(tid_));
    const int tid = tid_, wid = __builtin_amdgcn_readfirstlane(tid >> 6), lane = tid & 63, wr = wid >> 2, wc = wid & 3, fr = lane & 15, fq = lane >> 4;
    const int K = g.K, nt = K / BK;
    unsigned voffA[2], voffB[2];
#pragma unroll
    for (int i = 0; i < 2; ++i) { int R, C; stage_rc(tid * 16 + i * 8192, R, C); const int Rb = Epi::PERM ? ((R & ~31) + perm32(R & 31)) : R;
        voffA[i] = (unsigned)(R * K + C) * 2u; voffB[i] = (unsigned)(Rb * K + C) * 2u; }
    const size_t kstep = (size_t)(BK * 2);
    const size_t hstep = (size_t)HALF * K * 2;
    const size_t tstep = 2 * hstep;
    const unsigned ldsw = (unsigned)wid * 1024u;
    const int aoff = lds_byte(wr * 64 + fr, fq * 8), boff = lds_byte(wc * 32 + fr, fq * 8);
#define PG8_SA(b, h) (((b) * 2 + (h)) * HTB)
#define PG8_SB(b, h) ((4 + (b) * 2 + (h)) * HTB)
#define PG8_STAGE(bufoff, gbase, voff) do { _Pragma("unroll") for (int _i = 0; _i < 2; ++_i) \
        __builtin_amdgcn_global_load_lds((const unsigned*)((const char*)(gbase) + (voff)[_i]), (PG8_LAS unsigned*)(lds + (bufoff) + ldsw + _i * 8192), 16, 0, 0); } while (0)
#define PG8_LDA(dst, b, h) do { _Pragma("unroll") for (int m = 0; m < 4; ++m) _Pragma("unroll") for (int k = 0; k < 2; ++k) dst[m][k] = *(const PG8_LAS bf16x8*)(lds + PG8_SA(b, h) + aoff + m * 2048 + k * 1024); } while (0)
#define PG8_LDB(dst, b, h) do { _Pragma("unroll") for (int n = 0; n < 2; ++n) _Pragma("unroll") for (int k = 0; k < 2; ++k) dst[n][k] = *(const PG8_LAS bf16x8*)(lds + PG8_SB(b, h) + boff + n * 2048 + k * 1024); } while (0)
#define PG8_MMA(ai, bj, At, Bt) do { __builtin_amdgcn_s_setprio(1); _Pragma("unroll") for (int m = 0; m < 4; ++m) _Pragma("unroll") for (int n = 0; n < 2; ++n) _Pragma("unroll") for (int k = 0; k < 2; ++k) \
        acc[ai][bj][m][n] = __builtin_amdgcn_mfma_f32_16x16x32_bf16(Bt[n][k], At[m][k], acc[ai][bj][m][n], 0, 0, 0); __builtin_amdgcn_s_setprio(0); } while (0)
#define PG8_WAIT_V(n) asm volatile("s_waitcnt vmcnt(" #n ")" ::: "memory")
#define PG8_WAIT_L(n) asm volatile("s_waitcnt lgkmcnt(" #n ")" ::: "memory")
#define PG8_BAR __builtin_amdgcn_s_barrier()
#define PG8_SCHED __builtin_amdgcn_sched_barrier(0)
    Unit cur, nxt; int ui = 0;
    if (!S.next(0, cur)) return;
    f32x4 acc[2][2][4][2];
#pragma unroll
    for (int a = 0; a < 2; ++a)
#pragma unroll
        for (int b = 0; b < 2; ++b)
#pragma unroll
            for (int m = 0; m < 4; ++m)
#pragma unroll
                for (int n = 0; n < 2; ++n) acc[a][b][m][n] = (f32x4){0.f, 0.f, 0.f, 0.f};
    bf16x8 At[4][2], B0[2][2], B1[2][2];
    const char* cA = (const char*)g.A + (size_t)cur.pm * tstep; const char* cB = (const char*)g.Bt + (size_t)cur.pn * tstep;
    S.a_ready(cur);
    if constexpr (SP2) {
        PG8_STAGE(PG8_SB(0, 0), cB, voffB); PG8_STAGE(PG8_SB(0, 1), cB + hstep, voffB); PG8_STAGE(PG8_SA(0, 0), cA, voffA); PG8_STAGE(PG8_SA(0, 1), cA + hstep, voffA);
        if (wr == 1) PG8_BAR;
        PG8_WAIT_V(2); PG8_BAR;
        PG8_STAGE(PG8_SB(1, 0), cB + kstep, voffB); PG8_STAGE(PG8_SA(1, 0), cA + kstep, voffA); PG8_STAGE(PG8_SB(1, 1), cB + hstep + kstep, voffB);
        PG8_WAIT_V(6); PG8_BAR;
    } else {
        PG8_STAGE(PG8_SB(0, 0), cB, voffB); PG8_STAGE(PG8_SA(0, 0), cA, voffA); PG8_STAGE(PG8_SB(0, 1), cB + hstep, voffB); PG8_STAGE(PG8_SA(0, 1), cA + hstep, voffA);
        if (wr == 1) PG8_BAR;
        PG8_WAIT_V(4); PG8_BAR;
        PG8_STAGE(PG8_SB(1, 0), cB + kstep, voffB); PG8_STAGE(PG8_SA(1, 0), cA + kstep, voffA); PG8_STAGE(PG8_SB(1, 1), cB + hstep + kstep, voffB);
        PG8_WAIT_V(6); PG8_BAR;
    }
    for (;;) {
        const bool has_next = S.next(ui + 1, nxt);
        const char* nA = has_next ? (const char*)g.A + (size_t)nxt.pm * tstep : cA; const char* nB = has_next ? (const char*)g.Bt + (size_t)nxt.pn * tstep : cB;
        for (int t = 0; t < nt; t += 2) {
            const bool last = (t == nt - 2);
            const char* a1 = cA + (size_t)(t + 1) * kstep;
            const char* a2 = last ? nA : cA + (size_t)(t + 2) * kstep; const char* b2 = last ? nB : cB + (size_t)(t + 2) * kstep;
            const char* a3 = a2 + kstep; const char* b3 = b2 + kstep;
            if (last && has_next) S.a_ready(nxt);
            if constexpr (SP2) {
            PG8_LDB(B0, 0, 0); PG8_LDB(B1, 0, 1); PG8_SCHED; PG8_LDA(At, 0, 0); PG8_STAGE(PG8_SA(1, 1), a1 + hstep, voffA);
            PG8_WAIT_V(8); PG8_WAIT_L(0); PG8_BAR; PG8_MMA(0, 0, At, B0); PG8_MMA(0, 1, At, B1); PG8_BAR; PG8_SCHED;
            PG8_LDA(At, 0, 1); PG8_STAGE(PG8_SB(0, 0), b2, voffB); PG8_STAGE(PG8_SB(0, 1), b2 + hstep, voffB); PG8_STAGE(PG8_SA(0, 0), a2, voffA);
            PG8_WAIT_V(8); PG8_WAIT_L(0); PG8_BAR; PG8_MMA(1, 0, At, B0); PG8_MMA(1, 1, At, B1); PG8_BAR; PG8_SCHED;
            PG8_LDB(B0, 1, 0); PG8_LDB(B1, 1, 1); PG8_SCHED; PG8_LDA(At, 1, 0); PG8_STAGE(PG8_SA(0, 1), a2 + hstep, voffA);
            PG8_WAIT_V(8); PG8_WAIT_L(0); PG8_BAR; PG8_MMA(0, 0, At, B0); PG8_MMA(0, 1, At, B1); PG8_BAR; PG8_SCHED;
            PG8_LDA(At, 1, 1); PG8_STAGE(PG8_SB(1, 0), b3, voffB); PG8_STAGE(PG8_SB(1, 1), b3 + hstep, voffB); PG8_STAGE(PG8_SA(1, 0), a3, voffA);
            PG8_WAIT_V(8); PG8_WAIT_L(0); PG8_BAR; PG8_MMA(1, 0, At, B0); PG8_MMA(1, 1, At, B1); PG8_BAR; PG8_SCHED;
            } else {
            PG8_LDB(B0, 0, 0); PG8_SCHED; PG8_LDA(At, 0, 0); PG8_STAGE(PG8_SA(1, 1), a1 + hstep, voffA);
            PG8_WAIT_L(8); PG8_BAR; PG8_WAIT_L(0); PG8_MMA(0, 0, At, B0); PG8_BAR; PG8_SCHED;
            PG8_LDB(B1, 0, 1); PG8_STAGE(PG8_SB(0, 0), b2, voffB);
            PG8_BAR; PG8_WAIT_L(0); PG8_MMA(0, 1, At, B1); PG8_BAR;
            PG8_LDA(At, 0, 1); PG8_STAGE(PG8_SA(0, 0), a2, voffA);
            PG8_BAR; PG8_WAIT_L(0); PG8_MMA(1, 0, At, B0); PG8_BAR; PG8_SCHED;
            PG8_STAGE(PG8_SB(0, 1), b2 + hstep, voffB);
            PG8_WAIT_V(6); PG8_BAR; PG8_MMA(1, 1, At, B1); PG8_BAR;
            PG8_LDB(B0, 1, 0); PG8_SCHED; PG8_LDA(At, 1, 0); PG8_STAGE(PG8_SA(0, 1), a2 + hstep, voffA);
            PG8_WAIT_L(8); PG8_BAR; PG8_WAIT_L(0); PG8_MMA(0, 0, At, B0); PG8_BAR; PG8_SCHED;
            PG8_LDB(B1, 1, 1); PG8_STAGE(PG8_SB(1, 0), b3, voffB);
            PG8_BAR; PG8_WAIT_L(0); PG8_MMA(0, 1, At, B1); PG8_BAR;
            PG8_LDA(At, 1, 1); PG8_STAGE(PG8_SA(1, 0), a3, voffA);
            PG8_BAR; PG8_WAIT_L(0); PG8_MMA(1, 0, At, B0); PG8_BAR; PG8_SCHED;
            PG8_STAGE(PG8_SB(1, 1), b3 + hstep, voffB);
            PG8_WAIT_V(6); PG8_BAR; PG8_MMA(1, 1, At, B1); PG8_BAR;
            }
        }
        if constexpr (ALIGN_EPI) { if (wr == 0) PG8_BAR; }
        if constexpr (!Epi::AFTER_DRAIN) { E(acc, cur, wr, wc, fr, fq); S.done(cur); }
        if (!has_next) break;
#pragma unroll
        for (int a = 0; a < 2; ++a)
#pragma unroll
            for (int b = 0; b < 2; ++b)
#pragma unroll
                for (int m = 0; m < 4; ++m)
#pragma unroll
                    for (int n = 0; n < 2; ++n) acc[a][b][m][n] = (f32x4){0.f, 0.f, 0.f, 0.f};
        cur = nxt; cA = nA; cB = nB; ++ui;
        if constexpr (ALIGN_EPI) { if (wr == 1) PG8_BAR; }
    }
    PG8_WAIT_V(0);
    if constexpr (!ALIGN_EPI) { if (wr == 0) PG8_BAR; }
    PG8_BAR;
    if constexpr (Epi::AFTER_DRAIN) { E.fused(acc, cur, wr, wc, fr, fq, lds, wid, lane); S.done(cur); }
#undef PG8_SA
#undef PG8_SB
#undef PG8_STAGE
#undef PG8_LDA
#undef PG8_LDB
#undef PG8_MMA
#undef PG8_WAIT_V
#undef PG8_WAIT_L
#undef PG8_BAR
#undef PG8_SCHED
}
}

#define LAS __attribute__((address_space(3)))
typedef unsigned short bf16_t;
typedef float f32x4 __attribute__((ext_vector_type(4)));
typedef float f32x16 __attribute__((ext_vector_type(16)));
typedef unsigned u32x4 __attribute__((ext_vector_type(4)));
typedef unsigned u32x2 __attribute__((ext_vector_type(2)));
typedef short bf16x8 __attribute__((ext_vector_type(8)));

constexpr int DM = 1024, NB = 8, SEQ = 4096, NTOK = NB * SEQ, DEPTH = 2, DFF = 2816, NGU = 2 * DFF, NIN = 2304, NQKP = 1280;
constexpr int NWAVES = 8, NTHREADS = 512;
constexpr size_t MiB = 1u << 20;
constexpr size_t WS_WGU = 0, WS_WD = 44 * MiB, WS_WIN = 66 * MiB, WS_WOUT = 75 * MiB, WS_DFT = 80 * MiB, WS_ADA = 144 * MiB, WS_ROPE = 145 * MiB, WS_SCAL = 146 * MiB, WS_BARW = 147 * MiB,
                 WS_HY = 148 * MiB, WS_BIG = 212 * MiB, WS_QKP = WS_BIG, WS_VT = 292 * MiB, WS_FT = 324 * MiB, WS_MIX = 356 * MiB, WS_END = 420 * MiB;
constexpr int LDS_BYTES = 147456;

using pg8::cvt_pk_bf16;
__device__ __forceinline__ float bf2f(unsigned short b) { return __uint_as_float((unsigned)b << 16); }
__device__ __forceinline__ float wave_sum(float v) {
#pragma unroll
    for (int o = 1; o < 64; o <<= 1) v += __shfl_xor(v, o);
    return v;
}
#define LDS_WAIT() asm volatile("s_waitcnt lgkmcnt(0)" ::: "memory")

struct Args {
    const float* x; const float* c; const int* pos; const float* w_ada; const float* b_ada; const float* g_pre; const float* g_post;
    const float* w_gu; const float* w_down; const float* w_in; const float* w_f; const float* lq1; const float* lk1; const float* lq2; const float* lk2;
    const float* g_subln; const float* w_pool; const float* pool_scale; const float* w_out;
    float* out; unsigned char* ws; int ph_lo, ph_hi;
};

__device__ __forceinline__ void tr_item(const float* W, int ldw, int k0, int n0, bf16_t* WT, int ldt, int dbase, int dmul, float scale, LAS float* scr, int lane) {
#pragma unroll 8
    for (int i = 0; i < 32; ++i) { const int kk = 2 * i + (lane >> 5); scr[kk * 33 + (lane & 31)] = W[(size_t)(k0 + kk) * ldw + n0 + (lane & 31)]; }
    LDS_WAIT(); asm volatile("" ::: "memory");
    const int c = lane & 7;
#pragma unroll
    for (int j = 0; j < 4; ++j) { const int n = (lane >> 3) + 8 * j; const LAS float* s = scr + (8 * c) * 33 + n;
        u32x4 o; o.x = cvt_pk_bf16(s[0 * 33] * scale, s[1 * 33] * scale); o.y = cvt_pk_bf16(s[2 * 33] * scale, s[3 * 33] * scale);
        o.z = cvt_pk_bf16(s[4 * 33] * scale, s[5 * 33] * scale); o.w = cvt_pk_bf16(s[6 * 33] * scale, s[7 * 33] * scale);
        *(u32x4*)(WT + (size_t)(dbase + n * dmul) * ldt + k0 + 8 * c) = o; }
    LDS_WAIT(); asm volatile("" ::: "memory");
}

__device__ __forceinline__ void fold_apply(const float* Wsrc, int ncon, const LAS float* M, bf16_t* dst, int tid) {
#pragma unroll 1
    for (int i = 0; i < 2; ++i) { const int k = tid + 512 * i; float acc[16];
#pragma unroll
        for (int j = 0; j < 16; ++j) acc[j] = 0.f;
        const float* wr = Wsrc + (size_t)k * 2048;
#pragma unroll 1
        for (int hc = 0; hc < ncon; hc += 4) { const f32x4 w4 = *(const f32x4*)(wr + hc);
#pragma unroll
            for (int e = 0; e < 4; ++e) { const LAS f32x4* mp = (const LAS f32x4*)(M + (hc + e) * 16);
#pragma unroll
                for (int q = 0; q < 4; ++q) { const f32x4 mv = mp[q]; acc[4 * q] += w4[e] * mv[0]; acc[4 * q + 1] += w4[e] * mv[1]; acc[4 * q + 2] += w4[e] * mv[2]; acc[4 * q + 3] += w4[e] * mv[3]; } } }
#pragma unroll
        for (int j = 0; j < 16; ++j) dst[(size_t)j * 1024 + k] = (bf16_t)(cvt_pk_bf16(acc[j], 0.f) & 0xffffu); }
}

__device__ __forceinline__ void prologue(const Args& a, LAS unsigned char* lds, int G, int bid) {
    const int tid = threadIdx.x, lane = tid & 63, wave = __builtin_amdgcn_readfirstlane(tid >> 6);
    unsigned char* ws = a.ws;
    bf16_t* WGU = (bf16_t*)(ws + WS_WGU); bf16_t* WD = (bf16_t*)(ws + WS_WD); bf16_t* WIN = (bf16_t*)(ws + WS_WIN); bf16_t* WOUT = (bf16_t*)(ws + WS_WOUT);
    for (int it = bid; it < 384; it += G) {
        LAS float* Mf = (LAS float*)lds;
        if (it < 64) {
            const int l = it >> 5, part = (it >> 4) & 1, j0 = (it & 15) * 16;
            const float* wf = a.w_f + (size_t)l * 256 * 256;
#pragma unroll 1
            for (int i = 0; i < 8; ++i) { const int e = tid + 512 * i, hc = e >> 4, jj = e & 15, h = hc >> 6, cc = hc & 63; float s = 0.f;
#pragma unroll 4
                for (int cp = 0; cp < 64; ++cp) { const float rev = (float)((cc * cp) & 63) * (1.0f / 64.0f);
                    const float t = part ? __builtin_amdgcn_sinf(rev) : __builtin_amdgcn_cosf(rev);
                    s += t * wf[(size_t)(h * 64 + cp) * 256 + j0 + jj]; }
                Mf[hc * 16 + jj] = s * (1.0f / 512.0f); }
            __syncthreads();
            fold_apply(a.w_in + (size_t)l * 1024 * 2048, 256, Mf, WIN + ((size_t)l * NIN + 1280 + part * 256 + j0) * 1024, tid);
            __syncthreads();
        } else if (it < 96) {
            const int r = it - 64, l = r >> 4, g = (r >> 2) & 3, d0 = (r & 3) * 16;
            for (int e = tid; e < 1024; e += 512) { const int cc = e >> 4, dd = e & 15;
                Mf[e] = a.w_pool[(((size_t)l * 4 + g) * 64 + cc) * 64 + d0 + dd] * a.pool_scale[l * 256 + g * 64 + d0 + dd]; }
            __syncthreads();
            fold_apply(a.w_in + (size_t)l * 1024 * 2048 + 1792 + g * 64, 64, Mf, WIN + ((size_t)l * NIN + 1024 + g * 64 + d0) * 1024, tid);
            __syncthreads();
        } else {
            const int r = it - 96, l = r / 144, j0 = (r % 144) * 64;
            LAS float* cact = (LAS float*)lds;
            LAS float* red = (LAS float*)(lds + 32768);
            for (int e = tid; e < 8192; e += 512) { const float v = a.c[e]; cact[e] = v / (1.0f + __expf(-v)); }
            __syncthreads();
            const int col = tid & 63, kg = tid >> 6; float acc[8];
#pragma unroll
            for (int b = 0; b < 8; ++b) acc[b] = 0.f;
            const float* wp = a.w_ada + ((size_t)l * 1024 + kg * 128) * 9216 + j0 + col;
#pragma unroll 4
            for (int k = 0; k < 128; ++k) { const float w = wp[(size_t)k * 9216];
#pragma unroll
                for (int b = 0; b < 8; ++b) acc[b] += cact[b * 1024 + kg * 128 + k] * w; }
#pragma unroll
            for (int b = 0; b < 8; ++b) red[(kg * 8 + b) * 64 + col] = acc[b];
            __syncthreads();
            { const int b = tid >> 6; float s = 0.f;
#pragma unroll
              for (int q = 0; q < 8; ++q) s += red[(q * 8 + b) * 64 + col];
              ((float*)(ws + WS_ADA))[((size_t)l * 8 + b) * 9216 + j0 + col] = s + a.b_ada[(size_t)l * 9216 + j0 + col]; }
            __syncthreads();
        }
    }
    __syncthreads();
    {
        LAS float* scr = (LAS float*)(lds + wave * 16384);
        const int gw = bid * NWAVES + wave, NGW = G * NWAVES;
        constexpr int I_GU = 16 * 176, I_D = 44 * 32, I_IN = 16 * 48, I_O = 16 * 32;
        constexpr int NIT = 4 * I_GU + 4 * I_D + 2 * I_IN + 2 * I_O;
        for (int it = gw; it < NIT; it += NGW) {
            int r = it;
            if (r < 4 * I_GU) { const int mi = r / I_GU; r -= mi * I_GU; const int kb = r / 176, nb = r % 176, n0 = 32 * nb;
                const int j = n0 < DFF ? n0 : n0 - DFF; const int drow = j + 128 * (j / 128) + (n0 < DFF ? 0 : 128);
                tr_item(a.w_gu + (size_t)mi * 1024 * NGU, NGU, 64 * kb, n0, WGU + (size_t)mi * NGU * 1024, 1024, drow, 1, 1.f, scr, lane); continue; }
            r -= 4 * I_GU;
            if (r < 4 * I_D) { const int mi = r / I_D; r -= mi * I_D; const int kb = r / 32, nb = r % 32;
                tr_item(a.w_down + (size_t)mi * DFF * 1024, 1024, 64 * kb, 32 * nb, WD + (size_t)mi * 1024 * DFF, DFF, 32 * nb, 1, 1.f, scr, lane); continue; }
            r -= 4 * I_D;
            if (r < 2 * I_IN) { const int l = r / I_IN; r -= l * I_IN; const int kb = r / 48, nb = r % 48;
                int dbase, dmul; float sc = 1.f;
                if (nb < 32) { dbase = (nb >> 1) * 64 + (nb & 1); dmul = 2; if (nb < 16) sc = 0.125f * 1.4426950408889634f; }
                else { dbase = 1792 + 32 * (nb - 32); dmul = 1; }
                tr_item(a.w_in + (size_t)l * 1024 * 2048, 2048, 64 * kb, 256 + 32 * nb, WIN + (size_t)l * NIN * 1024, 1024, dbase, dmul, sc, scr, lane); continue; }
            r -= 2 * I_IN;
            { const int l = r / I_O; r -= l * I_O; const int kb = r / 32, nb = r % 32;
              tr_item(a.w_out + (size_t)l * 1024 * 1024, 1024, 64 * kb, 32 * nb, WOUT + (size_t)l * 1024 * 1024, 1024, 32 * nb, 1, 1.f, scr, lane); }
        }
    }
    {
        const size_t gt = (size_t)bid * NTHREADS + tid, NGT = (size_t)G * NTHREADS;
        bf16_t* DFT = (bf16_t*)(ws + WS_DFT);
        for (size_t e = gt; e < (size_t)4096 * 1024; e += NGT) { const int sp = (int)(e >> 10), k0 = (int)(e & 1023) * 8; float v[8];
#pragma unroll
            for (int j = 0; j < 8; ++j) { const int k = k0 + j; const float rev = (float)((sp * (k & 4095)) & 4095) * (1.0f / 4096.0f);
                v[j] = (k < 4096) ? __builtin_amdgcn_cosf(rev) : -__builtin_amdgcn_sinf(rev); }
            u32x4 o; o.x = cvt_pk_bf16(v[0], v[1]); o.y = cvt_pk_bf16(v[2], v[3]); o.z = cvt_pk_bf16(v[4], v[5]); o.w = cvt_pk_bf16(v[6], v[7]);
            *(u32x4*)(DFT + (size_t)sp * 8192 + k0) = o; }
        float* rope = (float*)(ws + WS_ROPE);
        for (size_t e = gt; e < (size_t)4096 * 32; e += NGT) { const int s = (int)(e >> 5), i = (int)(e & 31);
            const float inv = 1.0f / __builtin_exp2f((float)i * (13.287712379549449f / 32.0f));
            const float ang = (float)a.pos[s] * inv;
            const double rv = (double)ang * 0.15915494309189535; const double fr = rv - __builtin_rint(rv); const float f = (float)fr;
            rope[e * 2] = __builtin_amdgcn_cosf(f); rope[e * 2 + 1] = __builtin_amdgcn_sinf(f); }
        if (gt < 2) { const int l = (int)gt; float s1 = 0.f, s2 = 0.f;
            for (int i = 0; i < 64; ++i) { s1 += a.lq1[l * 64 + i] * a.lk1[l * 64 + i]; s2 += a.lq2[l * 64 + i] * a.lk2[l * 64 + i]; }
            const float li = 0.8f - 0.6f * __expf(-0.3f * (float)l);
            float* sc = (float*)(ws + WS_SCAL); sc[2 * l] = __expf(s1) - __expf(s2) + li; sc[2 * l + 1] = 1.0f - li; }
    }
}

template <bool HAS_Y, bool HAS_NORM>
__device__ __forceinline__ void thin_phase(const Args& a, const float* xsrc, int lpost, int sub_post, float wres, int lpre, int sub_pre, int G, int bid) {
    int tid_ = threadIdx.x; asm volatile("" : "+v"(tid_));
    const int tid = tid_, lane = tid & 63, wave = tid >> 6;
    const float* ada = (const float*)(a.ws + WS_ADA); bf16_t* HY = (bf16_t*)(a.ws + WS_HY);
    for (int rb = bid * NWAVES + wave; rb < NTOK / 16; rb += G * NWAVES) {
        const int row0 = rb * 16, b = row0 >> 12;
        f32x4 cg_[4], gs[4], sh[4];
#pragma unroll
        for (int j = 0; j < 4; ++j) { const int col = 4 * (lane + 64 * j);
            if (HAS_Y) { const f32x4 gate = *(const f32x4*)(ada + ((size_t)(lpost * 8 + b) * 9 + sub_post * 3 + 2) * 1024 + col);
                const f32x4 gp = *(const f32x4*)(a.g_post + (size_t)(lpost * 3 + sub_post) * 1024 + col); cg_[j] = gate * gp * wres; }
            if (HAS_NORM) { const f32x4 gpre = *(const f32x4*)(a.g_pre + (size_t)(lpre * 3 + sub_pre) * 1024 + col);
                const f32x4 scl = *(const f32x4*)(ada + ((size_t)(lpre * 8 + b) * 9 + sub_pre * 3 + 1) * 1024 + col);
                sh[j] = *(const f32x4*)(ada + ((size_t)(lpre * 8 + b) * 9 + sub_pre * 3 + 0) * 1024 + col); gs[j] = gpre * (scl + 1.0f); } }
#pragma unroll 2
        for (int rr = 0; rr < 16; ++rr) { const size_t ro = (size_t)(row0 + rr) * 1024;
            f32x4 x[4];
#pragma unroll
            for (int j = 0; j < 4; ++j) x[j] = *(const f32x4*)(xsrc + ro + 4 * (lane + 64 * j));
            if (HAS_Y) { f32x4 y[4]; float ss = 0.f;
#pragma unroll
                for (int j = 0; j < 4; ++j) { const u32x2 yw = *(const u32x2*)(HY + ro + 4 * (lane + 64 * j));
                    y[j][0] = __uint_as_float(yw.x << 16); y[j][1] = __uint_as_float(yw.x & 0xffff0000u); y[j][2] = __uint_as_float(yw.y << 16); y[j][3] = __uint_as_float(yw.y & 0xffff0000u);
                    ss += (y[j][0] * y[j][0] + y[j][1] * y[j][1]) + (y[j][2] * y[j][2] + y[j][3] * y[j][3]); }
                const float rstd = 1.0f / sqrtf(wave_sum(ss) * (1.0f / 1024.0f) + 1e-6f);
#pragma unroll
                for (int j = 0; j < 4; ++j) { x[j] = x[j] + cg_[j] * y[j] * rstd; *(f32x4*)(a.out + ro + 4 * (lane + 64 * j)) = x[j]; } }
            if (HAS_NORM) { float ss = 0.f;
#pragma unroll
                for (int j = 0; j < 4; ++j) ss += (x[j][0] * x[j][0] + x[j][1] * x[j][1]) + (x[j][2] * x[j][2] + x[j][3] * x[j][3]);
                const float rstd = 1.0f / sqrtf(wave_sum(ss) * (1.0f / 1024.0f) + 1e-6f);
#pragma unroll
                for (int j = 0; j < 4; ++j) { const f32x4 hv = x[j] * rstd * gs[j] + sh[j]; u32x2 w; w.x = cvt_pk_bf16(hv[0], hv[1]); w.y = cvt_pk_bf16(hv[2], hv[3]);
                    *(u32x2*)(HY + ro + 4 * (lane + 64 * j)) = w; } }
        }
    }
}

namespace att {
constexpr int ROWB = 144, KBY = 64 * ROWB, STAGE = 2 * KBY + 128 * ROWB;
#define MFMA32(a_, b_, c_) __builtin_amdgcn_mfma_f32_32x32x16_bf16((a_), (b_), (c_), 0, 0, 0)
__device__ __forceinline__ float swapmax(float m) { auto rr = __builtin_amdgcn_permlane32_swap(__float_as_uint(m), __float_as_uint(m), false, false); return __builtin_fmaxf(__uint_as_float(rr[0]), __uint_as_float(rr[1])); }
__device__ __forceinline__ float swapsum(float m) { auto rr = __builtin_amdgcn_permlane32_swap(__float_as_uint(m), __float_as_uint(m), false, false); return __uint_as_float(rr[0]) + __uint_as_float(rr[1]); }
__device__ __forceinline__ bf16x8 pack8(const f32x16& p, int s) { u32x4 w; w.x = cvt_pk_bf16(p[8 * s], p[8 * s + 1]); w.y = cvt_pk_bf16(p[8 * s + 2], p[8 * s + 3]); w.z = cvt_pk_bf16(p[8 * s + 4], p[8 * s + 5]); w.w = cvt_pk_bf16(p[8 * s + 6], p[8 * s + 7]); return __builtin_bit_cast(bf16x8, w); }

__device__ __forceinline__ void attn_unit(LAS unsigned char* lds, const bf16_t* QKP, const bf16_t* VT, bf16_t* MIX, int b, int h, int qb, float lam, float oml, const float* gsub) {
    int tid_ = threadIdx.x; asm volatile("" : "+v"(tid_));
    const int tid = tid_, lane = tid & 63, wid = __builtin_amdgcn_readfirstlane(tid >> 6), r32 = lane & 31, hi = lane >> 5, map = wid >> 2, rg = wid & 3;
    const size_t tok0 = (size_t)b * SEQ;
    const int lkey = tid >> 3, lch = tid & 7;
    const bf16_t* kg0 = QKP + (tok0 + lkey) * NQKP + 512 + (2 * h) * 64 + lch * 8;
    const bf16_t* vg0 = VT + (size_t)(h * 128 + lkey) * NTOK + tok0 + lch * 8;
    const int lk_off = lkey * ROWB + lch * 16, lv_off = 2 * KBY + lkey * ROWB + lch * 16;
    u32x4 kr0, kr1, vr0, vr1;
#define ATT_LOAD(t) do { kr0 = *(const u32x4*)(kg0 + (size_t)(t) * 64 * NQKP); kr1 = *(const u32x4*)(kg0 + (size_t)(t) * 64 * NQKP + 64); \
                         vr0 = *(const u32x4*)(vg0 + (t) * 64); vr1 = *(const u32x4*)(vg0 + (size_t)64 * NTOK + (t) * 64); } while (0)
#define ATT_STORE(st) do { LAS unsigned char* sb_ = lds + (st) * STAGE; *(LAS u32x4*)(sb_ + lk_off) = kr0; *(LAS u32x4*)(sb_ + KBY + lk_off) = kr1; \
                           *(LAS u32x4*)(sb_ + lv_off) = vr0; *(LAS u32x4*)(sb_ + lv_off + 64 * ROWB) = vr1; } while (0)
    ATT_LOAD(0);
    const bf16_t* qg = QKP + (tok0 + qb * 128 + rg * 32 + r32) * NQKP + (2 * h + map) * 64 + hi * 8;
    bf16x8 qr[4];
#pragma unroll
    for (int d0 = 0; d0 < 4; ++d0) qr[d0] = *(const bf16x8*)(qg + d0 * 16);
    const int m16 = r32 & 15, g4 = m16 >> 2, g4p = (g4 == 1) ? 2 : (g4 == 2) ? 1 : g4, prow = (r32 & 16) | (g4p << 2) | (r32 & 3);
    const int kfa = map * KBY + prow * ROWB + hi * 16, vfa = 2 * KBY + r32 * ROWB + hi * 16;
    f32x16 o[4];
#pragma unroll
    for (int v = 0; v < 4; ++v)
#pragma unroll
        for (int r = 0; r < 16; ++r) o[v][r] = 0.f;
    float mhat = 0.f, lsum = 0.f;
    ATT_STORE(0);
    __syncthreads();
#define ATT_SB() __builtin_amdgcn_sched_barrier(0)
#pragma unroll 1
    for (int t = 0; t < 64; ++t) {
        const int st = t & 1;
        { const int tn = (t + 1 < 64) ? t + 1 : 63; ATT_LOAD(tn); }
        const LAS unsigned char* sb = lds + st * STAGE;
        bf16x8 kf[8];
#pragma unroll
        for (int d0 = 0; d0 < 4; ++d0) { kf[2 * d0] = *(const LAS bf16x8*)(sb + kfa + d0 * 32); kf[2 * d0 + 1] = *(const LAS bf16x8*)(sb + kfa + 32 * ROWB + d0 * 32); }
        ATT_SB();
        f32x16 p0, p1;
#pragma unroll
        for (int r = 0; r < 16; ++r) { p0[r] = -mhat; p1[r] = -mhat; }
#pragma unroll
        for (int d0 = 0; d0 < 4; ++d0) { p0 = MFMA32(kf[2 * d0], qr[d0], p0); p1 = MFMA32(kf[2 * d0 + 1], qr[d0], p1); }
        ATT_SB();
        bf16x8 va[8];
#pragma unroll
        for (int v = 0; v < 2; ++v)
#pragma unroll
            for (int ks = 0; ks < 4; ++ks) va[v * 4 + ks] = *(const LAS bf16x8*)(sb + vfa + v * 32 * ROWB + ks * 32);
        ATT_SB();
        float rm = __builtin_fmaxf(p0[0], p1[0]);
#pragma unroll
        for (int r = 1; r < 16; ++r) rm = __builtin_fmaxf(rm, __builtin_fmaxf(p0[r], p1[r]));
        rm = swapmax(rm);
        const bool first = (t == 0);
        if (first || __any(rm > 8.0f)) {
            const float dl = first ? rm : __builtin_fmaxf(rm, 0.f); mhat += dl;
#pragma unroll
            for (int r = 0; r < 16; ++r) { p0[r] -= dl; p1[r] -= dl; }
            if (!first) { const float al = __builtin_amdgcn_exp2f(-dl); lsum *= al;
#pragma unroll
                for (int v = 0; v < 4; ++v)
#pragma unroll
                    for (int r = 0; r < 16; ++r) o[v][r] *= al; }
        }
        float sacc = 0.f;
#pragma unroll
        for (int r = 0; r < 16; ++r) { p0[r] = __builtin_amdgcn_exp2f(p0[r]); p1[r] = __builtin_amdgcn_exp2f(p1[r]); sacc += p0[r] + p1[r]; }
        lsum += sacc;
        bf16x8 pf[4]; pf[0] = pack8(p0, 0); pf[1] = pack8(p0, 1); pf[2] = pack8(p1, 0); pf[3] = pack8(p1, 1);
        ATT_SB();
#pragma unroll
        for (int v = 0; v < 2; ++v)
#pragma unroll
            for (int ks = 0; ks < 4; ++ks) kf[v * 4 + ks] = *(const LAS bf16x8*)(sb + vfa + (v + 2) * 32 * ROWB + ks * 32);
        ATT_SB();
#pragma unroll
        for (int ks = 0; ks < 4; ++ks) { o[0] = MFMA32(va[ks], pf[ks], o[0]); o[1] = MFMA32(va[4 + ks], pf[ks], o[1]); }
        ATT_SB();
#pragma unroll
        for (int ks = 0; ks < 4; ++ks) { o[2] = MFMA32(kf[ks], pf[ks], o[2]); o[3] = MFMA32(kf[4 + ks], pf[ks], o[3]); }
        ATT_SB();
        if (t + 1 < 64) ATT_STORE(st ^ 1);
        __syncthreads();
    }
#undef ATT_SB
#undef ATT_LOAD
#undef ATT_STORE
    const float inv = 1.0f / swapsum(lsum);
#pragma unroll
    for (int v = 0; v < 4; ++v)
#pragma unroll
        for (int r = 0; r < 16; ++r) o[v][r] *= inv;
    LAS float* cmb = (LAS float*)lds;
    if (map == 1) {
#pragma unroll
        for (int v = 0; v < 4; ++v)
#pragma unroll
            for (int r = 0; r < 16; ++r) cmb[(rg * 64 + v * 16 + r) * 64 + lane] = o[v][r];
    }
    __syncthreads();
    if (map == 0) {
        float ss = 0.f;
#pragma unroll
        for (int v = 0; v < 4; ++v)
#pragma unroll
            for (int r = 0; r < 16; ++r) { const float d = o[v][r] - lam * cmb[(rg * 64 + v * 16 + r) * 64 + lane]; o[v][r] = d; ss += d * d; }
        ss = swapsum(ss);
        const float rstd = oml / sqrtf(ss * (1.0f / 128.0f) + 1e-5f);
        bf16_t* op = MIX + (tok0 + qb * 128 + rg * 32 + r32) * 1024 + 256 + h * 128;
#pragma unroll
        for (int v = 0; v < 4; ++v)
#pragma unroll
            for (int q = 0; q < 4; ++q) { const int vc = 32 * v + 8 * q + 4 * hi; const f32x4 g = *(const f32x4*)(gsub + vc);
                u32x2 w; w.x = cvt_pk_bf16(o[v][4 * q] * rstd * g[0], o[v][4 * q + 1] * rstd * g[1]); w.y = cvt_pk_bf16(o[v][4 * q + 2] * rstd * g[2], o[v][4 * q + 3] * rstd * g[3]);
                *(u32x2*)(op + vc) = w; }
    }
    __syncthreads();
}
}

template <int HF> __device__ __forceinline__ void pool_body(const bf16_t* zp, bf16_t* op, int s0) {
    u32x4 zz[8 + 2 * HF];
#pragma unroll
    for (int i = 0; i < 8 + 2 * HF; ++i) { const int s = s0 - HF + i; zz[i] = (s >= 0 && s < SEQ) ? *(const u32x4*)(zp + (ptrdiff_t)(s - s0) * NQKP) : (u32x4){0u, 0u, 0u, 0u}; }
    float w[8];
#pragma unroll
    for (int e = 0; e < 8; ++e) w[e] = 0.f;
#define POOL_Z(i, e) (((e) & 1) ? __uint_as_float(zz[i][(e) >> 1] & 0xffff0000u) : __uint_as_float(zz[i][(e) >> 1] << 16))
#pragma unroll
    for (int i = 0; i < 2 * HF; ++i)
#pragma unroll
        for (int e = 0; e < 8; ++e) w[e] += POOL_Z(i, e);
#pragma unroll
    for (int tk = 0; tk < 8; ++tk) { const int s = s0 + tk; const int lo = s - HF < 0 ? 0 : s - HF, hi = s + HF > SEQ ? SEQ : s + HF; const float ic = 1.0f / (float)(hi - lo);
        float o[8];
#pragma unroll
        for (int e = 0; e < 8; ++e) { o[e] = w[e] * ic - POOL_Z(HF + tk, e); w[e] += POOL_Z(2 * HF + tk, e) - POOL_Z(tk, e); }
        u32x4 ov; ov.x = cvt_pk_bf16(o[0], o[1]); ov.y = cvt_pk_bf16(o[2], o[3]); ov.z = cvt_pk_bf16(o[4], o[5]); ov.w = cvt_pk_bf16(o[6], o[7]);
        *(u32x4*)(op + (size_t)tk * 1024) = ov; }
#undef POOL_Z
}
__device__ __forceinline__ void pool_block(const bf16_t* QKP, bf16_t* MIX, int item) {
    const int tid = threadIdx.x, lane = tid & 63, wave = __builtin_amdgcn_readfirstlane(tid >> 6), g = wave & 3, sub = lane & 7;
    const int tg = (item * 2 + (wave >> 2)) * 8 + (lane >> 3), b = tg >> 9, s0 = (tg & 511) * 8;
    const bf16_t* zp = QKP + ((size_t)b * SEQ + s0) * NQKP + 1024 + g * 64 + sub * 8;
    bf16_t* op = MIX + ((size_t)b * SEQ + s0) * 1024 + 768 + g * 64 + sub * 8;
    if (g == 0) pool_body<1>(zp, op, s0); else if (g == 1) pool_body<2>(zp, op, s0); else if (g == 2) pool_body<4>(zp, op, s0); else pool_body<8>(zp, op, s0);
}

#ifndef NO_ATT
#define ATTN_CALL(u) att::attn_unit(lds, QKP, VT, MIX, (u) >> 7, ((u) >> 5) & 3, (u) & 31, lam, oml, gsub)
#else
#define ATTN_CALL(u) (void)0
#endif
#ifdef NO_GEMM
#define GEMM_PHASE(...) (void)0
#else
#define GEMM_PHASE(...) pg8::gemm_phase<__VA_ARGS__>
#endif
typedef unsigned v4u __attribute__((ext_vector_type(4)));
#define XB_TMO      128
#define XB_XCNT(j)  (256  + 64 * (j))
#define XB_XSUB(j)  (1280 + 64 * (j))
#define XB_XGEN(j)  (2304 + 64 * (j))
#define XB_TOP      3328
#define XB_TOPGEN   3392
#define XCD_BAR_WORDS 3456
#define XB_SPIN_CAP (1u << 18)

__device__ __forceinline__ unsigned xb_ld(unsigned* p)              { return __hip_atomic_load(p, __ATOMIC_RELAXED, __HIP_MEMORY_SCOPE_AGENT); }
__device__ __forceinline__ unsigned xb_add(unsigned* p, unsigned v) { return __hip_atomic_fetch_add(p, v, __ATOMIC_RELAXED, __HIP_MEMORY_SCOPE_AGENT); }
__device__ __forceinline__ unsigned xb_xcc_id() { return (unsigned)__builtin_amdgcn_s_getreg((3 << 11) | 20) & 0xFu; }
#define XB_SPIN(cond, bar) do { unsigned _sp = 0; while (cond) { __builtin_amdgcn_s_sleep(1); \
    if ((++_sp & 255u) == 0u) { if (xb_ld(&(bar)[XB_TMO])) break; if (_sp > XB_SPIN_CAP) { atomicAdd(&(bar)[XB_TMO], 1u); break; } } } } while (0)

struct XcdBarrier {
    unsigned* bar; unsigned x;
    volatile LAS unsigned* st;
};

__device__ __forceinline__ XcdBarrier xcd_barrier_post(unsigned* bar, volatile LAS unsigned* st) {
    XcdBarrier b; b.bar = bar; b.x = xb_xcc_id(); b.st = st;
    if (threadIdx.x == 0) (void)xb_add(&bar[XB_XCNT(b.x)], 1u);
    return b;
}
__device__ __forceinline__ void xcd_barrier_complete(unsigned* bar, unsigned x, unsigned& nloc, unsigned& nx) {
    const unsigned G = gridDim.x * gridDim.y * gridDim.z;
    unsigned sum, cnt, mine, sp = 0u;
    for (;;) {
        sum = 0u; cnt = 0u; mine = 0u;
#pragma unroll
        for (unsigned j = 0; j < 16; ++j) { const unsigned c = xb_ld(&bar[XB_XCNT(j)]); sum += c; cnt += (c > 0u) ? 1u : 0u; mine = (j == x) ? c : mine; }
        if (sum == G) break;
        __builtin_amdgcn_s_sleep(1);
        if ((++sp & 255u) == 0u) { if (xb_ld(&bar[XB_TMO])) break; if (sp > XB_SPIN_CAP) { atomicAdd(&bar[XB_TMO], 1u); break; } }
    }
    nloc = mine > 0u ? mine : 1u; nx = cnt > 0u ? cnt : 1u;
}

__device__ __forceinline__ void xcd_barrier(const XcdBarrier& b) {
    asm volatile("s_waitcnt vmcnt(0)" ::: "memory");
    __syncthreads();
    if (threadIdx.x == 0) {
        unsigned* bar = b.bar;
        __builtin_amdgcn_s_waitcnt(0);
        unsigned nloc = b.st[0], nx = b.st[1];
        if (nloc == 0u) { xcd_barrier_complete(bar, b.x, nloc, nx); b.st[0] = nloc; b.st[1] = nx; }
        const unsigned old = xb_add(&bar[XB_XSUB(b.x)], 1u);
        const unsigned gen = old / nloc;
        if (old + 1u == (gen + 1u) * nloc) {
            __builtin_amdgcn_fence(__ATOMIC_RELEASE, "agent");
            asm volatile("s_waitcnt vmcnt(0)" ::: "memory");
            const unsigned og = xb_add(&bar[XB_TOP], 1u);
            const unsigned tg = og / nx;
            if (og + 1u == (tg + 1u) * nx) xb_add(&bar[XB_TOPGEN], 1u);
            else XB_SPIN(xb_ld(&bar[XB_TOPGEN]) == tg, bar);
            __builtin_amdgcn_fence(__ATOMIC_ACQUIRE, "agent");
            xb_add(&bar[XB_XGEN(b.x)], 1u);
            asm volatile("s_waitcnt vmcnt(0)" ::: "memory");
        } else {
            XB_SPIN(xb_ld(&bar[XB_XGEN(b.x)]) == gen, bar);
            __builtin_amdgcn_fence(__ATOMIC_ACQUIRE, "agent");
            asm volatile("s_waitcnt vmcnt(0)" ::: "memory");
        }
    }
    __syncthreads();
}

typedef const __attribute__((address_space(4))) Args* CArgsP;
#if defined(__HIP_DEVICE_COMPILE__)
__device__ __forceinline__ Args load_args() { CArgsP p = (CArgsP)__builtin_amdgcn_kernarg_segment_ptr(); asm volatile("" : "+s"(p)); return *p; }
#else
__device__ __forceinline__ Args load_args() { return Args{}; }
#endif
__global__ void __launch_bounds__(NTHREADS, 2) fwd_kernel(Args a_in) {
    extern __shared__ __attribute__((aligned(16))) unsigned char lds_raw[];
    LAS unsigned char* lds = (LAS unsigned char*)lds_raw;
    const int G0 = gridDim.x, bid0 = blockIdx.x;
    const int lo = a_in.ph_lo, hi = a_in.ph_hi;
    volatile LAS unsigned* xst = (volatile LAS unsigned*)(lds + 131072 + 64);
    if (threadIdx.x < 2) xst[threadIdx.x] = 0u;
    if (bid0 == 0) { unsigned* bw = (unsigned*)(a_in.ws + WS_BARW); for (int i = threadIdx.x; i < XCD_BAR_WORDS; i += NTHREADS) bw[i] = 0u; }
    __syncthreads();
    XcdBarrier xbar; xbar.bar = nullptr; xbar.x = 0; xbar.st = nullptr; bool bar_up = false;
    int ph = 0; int l0 = 0, f0 = 0;
#define PHASE_BEGIN if (ph >= lo && ph < hi) { const Args a = load_args(); unsigned char* ws = a.ws; int G = G0, bid = bid0, l = l0, f = f0; asm volatile("" : "+s"(G), "+s"(bid), "+s"(l), "+s"(f)); \
    const int vcu = (G % 8 == 0) ? (bid % 8) * (G / 8) + bid / 8 : bid; (void)vcu; (void)l; (void)f; \
    bf16_t* WGU = (bf16_t*)(ws + WS_WGU); bf16_t* WD = (bf16_t*)(ws + WS_WD); bf16_t* WIN = (bf16_t*)(ws + WS_WIN); bf16_t* WOUT = (bf16_t*)(ws + WS_WOUT); \
    bf16_t* DFT = (bf16_t*)(ws + WS_DFT); bf16_t* HY = (bf16_t*)(ws + WS_HY); bf16_t* HID = (bf16_t*)(ws + WS_BIG); \
    bf16_t* QKP = (bf16_t*)(ws + WS_QKP); bf16_t* VT = (bf16_t*)(ws + WS_VT); bf16_t* FT = (bf16_t*)(ws + WS_FT); bf16_t* MIX = (bf16_t*)(ws + WS_MIX); \
    const float* rope = (const float*)(ws + WS_ROPE); const float* scal = (const float*)(ws + WS_SCAL); \
    (void)WGU; (void)WD; (void)WIN; (void)WOUT; (void)DFT; (void)HY; (void)HID; (void)QKP; (void)VT; (void)FT; (void)MIX; (void)rope; (void)scal;
#define PHASE_END   if (ph + 1 < hi) { if (!bar_up) { cg::this_grid().sync(); xbar = xcd_barrier_post((unsigned*)(a.ws + WS_BARW), xst); bar_up = true; } else xcd_barrier(xbar); } } ++ph;

#ifndef NO_PRO
    PHASE_BEGIN prologue(a, lds, G, bid); PHASE_END
#endif
    PHASE_BEGIN thin_phase<false, true>(a, a.x, 0, 0, 0.f, 0, 0, G, bid); PHASE_END
#ifdef PROBE_SYNC
    for (int i_ = 0; i_ < 20; ++i_) xcd_barrier(xbar);
#endif
#pragma unroll 1
    for (l0 = 0; l0 < DEPTH; ++l0) {
#pragma unroll 1
        for (f0 = 0; f0 < 2; ++f0) {
            if (f0 == 1) {
                PHASE_BEGIN
                { pg8::Gemm g{HY, WIN + (size_t)l * NIN * 1024, NTOK, NQKP, 1024}; pg8::StaticOrder S; S.init(NTOK, NQKP, G, bid); pg8::EpiRope E{QKP, rope};
                  GEMM_PHASE(pg8::EpiRope, pg8::StaticOrder, true, true)(lds, g, S, E); }
                { pg8::Gemm g{WIN + ((size_t)l * NIN + 1280) * 1024, HY, 1024, NTOK, 1024}; pg8::StaticOrder S; S.init(1024, NTOK, G, bid); pg8::EpiChanMajor E{FT, VT};
                  GEMM_PHASE(pg8::EpiChanMajor, pg8::StaticOrder, true, true)(lds, g, S, E); }
                PHASE_END
                PHASE_BEGIN
#ifdef PROBE_MIX
                for (int rep_ = 0; rep_ < 2; ++rep_) {
#endif
                for (int it = vcu; it < 256; it += G) pool_block(QKP, MIX, it);
                __syncthreads();
                const int xc = vcu >> 5, jl = vcu & 31;
                { pg8::Gemm g{DFT, FT, SEQ, NB * 256, 2 * SEQ}; pg8::DftOrder S; S.G = G; S.c = (G == 256) ? (jl < 16 ? xc * 16 + jl : 128) : bid;
                  pg8::EpiBf16 E{MIX, 1024, 256, (size_t)SEQ * 1024};
                  GEMM_PHASE(pg8::EpiBf16, pg8::DftOrder, true, true)(lds, g, S, E);
#ifdef PROBE_DFT
                  __syncthreads(); GEMM_PHASE(pg8::EpiBf16, pg8::DftOrder, true, true)(lds, g, S, E);
#endif
                }
                __syncthreads();
                { const float lam = scal[2 * l], oml = scal[2 * l + 1]; const float* gsub = a.g_subln + l * 128;
                  if (G == 256) { const int u0 = jl < 16 ? 3 * jl : 48 + 5 * (jl - 16), nu = jl < 16 ? 3 : 5;
                      for (int i = 0; i < nu; ++i) { const int u = xc * 128 + u0 + i; ATTN_CALL(u);
#ifdef PROBE_ATT
                          ATTN_CALL(u);
#endif
                      } }
                  else for (int u = bid; u < 1024; u += G) ATTN_CALL(u); }
#ifdef PROBE_MIX
                __syncthreads(); }
#endif
                PHASE_END
                PHASE_BEGIN
                { pg8::Gemm g{MIX, WOUT + (size_t)l * 1024 * 1024, NTOK, 1024, 1024}; pg8::StaticOrder S; S.init(NTOK, 1024, G, bid); pg8::EpiBf16 E{HY, 1024, 0, 0};
                  GEMM_PHASE(pg8::EpiBf16, pg8::StaticOrder, true, true)(lds, g, S, E); }
                PHASE_END
                PHASE_BEGIN thin_phase<true, true>(a, a.out, l, 1, 1.0f, l, 2, G, bid); PHASE_END
            }
            PHASE_BEGIN
            { pg8::Gemm g{HY, WGU + (size_t)(l * 2 + f) * NGU * 1024, NTOK, NGU, 1024}; pg8::StaticOrder S; S.init(NTOK, NGU, G, bid); pg8::EpiSwiglu E{HID, DFF};
              GEMM_PHASE(pg8::EpiSwiglu, pg8::StaticOrder, true, true)(lds, g, S, E);
#ifdef PROBE_GU
              __syncthreads(); GEMM_PHASE(pg8::EpiSwiglu, pg8::StaticOrder, true, true)(lds, g, S, E);
#endif
            }
            PHASE_END
            PHASE_BEGIN
            { pg8::Gemm g{HID, WD + (size_t)(l * 2 + f) * 1024 * DFF, NTOK, 1024, DFF}; pg8::StaticOrder S; S.init(NTOK, 1024, G, bid); pg8::EpiBf16 E{HY, 1024, 0, 0};
              GEMM_PHASE(pg8::EpiBf16, pg8::StaticOrder, true, true)(lds, g, S, E); }
            PHASE_END
            if (f0 == 0) { PHASE_BEGIN thin_phase<true, true>(a, (l == 0) ? a.x : a.out, l, 0, 0.5f, l, 1, G, bid); PHASE_END }
            else if (l0 + 1 < DEPTH) { PHASE_BEGIN thin_phase<true, true>(a, a.out, l, 2, 0.5f, l + 1, 0, G, bid); PHASE_END }
            else { PHASE_BEGIN thin_phase<true, false>(a, a.out, l, 2, 0.5f, 0, 0, G, bid); PHASE_END }
        }
    }
#undef PHASE_BEGIN
#undef PHASE_END
}

constexpr int N_PHASES = 2 + DEPTH * 10;

extern "C" void kernel_launch(void* const* d_in, const int* in_sizes, int n_in, void* d_out, int out_size, void* d_ws, size_t ws_size, hipStream_t stream) {
    static int grid = 0;
    if (grid == 0) {
        if (n_in != 19 || ws_size < WS_END) { fprintf(stderr, "kernel_launch: unexpected inputs (n_in %d, ws %zu)\n", n_in, ws_size); grid = -1; return; }
        int dev = 0, cus = 0, per_cu = 0;
        hipGetDevice(&dev); hipDeviceGetAttribute(&cus, hipDeviceAttributeMultiprocessorCount, dev);
        if (hipFuncSetAttribute((const void*)fwd_kernel, hipFuncAttributeMaxDynamicSharedMemorySize, LDS_BYTES) != hipSuccess) { fprintf(stderr, "kernel_launch: hipFuncSetAttribute failed\n"); grid = -1; return; }
        if (hipOccupancyMaxActiveBlocksPerMultiprocessor(&per_cu, (const void*)fwd_kernel, NTHREADS, LDS_BYTES) != hipSuccess || per_cu < 1) { fprintf(stderr, "kernel_launch: occupancy query says %d\n", per_cu); per_cu = 1; }
        (void)hipGetLastError();
        grid = cus * 1;
        fprintf(stderr, "kernel_launch: grid %d (cus %d, per_cu %d)\n", grid, cus, per_cu);
    }
    if (grid < 0) return;
    Args a{};
    a.x = (const float*)d_in[0]; a.c = (const float*)d_in[1]; a.pos = (const int*)d_in[2]; a.w_ada = (const float*)d_in[3]; a.b_ada = (const float*)d_in[4];
    a.g_pre = (const float*)d_in[5]; a.g_post = (const float*)d_in[6]; a.w_gu = (const float*)d_in[7]; a.w_down = (const float*)d_in[8]; a.w_in = (const float*)d_in[9];
    a.w_f = (const float*)d_in[10]; a.lq1 = (const float*)d_in[11]; a.lk1 = (const float*)d_in[12]; a.lq2 = (const float*)d_in[13]; a.lk2 = (const float*)d_in[14];
    a.g_subln = (const float*)d_in[15]; a.w_pool = (const float*)d_in[16]; a.pool_scale = (const float*)d_in[17]; a.w_out = (const float*)d_in[18];
    a.out = (float*)d_out; a.ws = (unsigned char*)d_ws; a.ph_lo = 0; a.ph_hi = N_PHASES;
    void* args[] = {&a};
    hipError_t e = hipLaunchCooperativeKernel((const void*)fwd_kernel, dim3(grid), dim3(NTHREADS), args, LDS_BYTES, stream);
    if (e != hipSuccess) fprintf(stderr, "kernel_launch: cooperative launch failed: %s (grid %d)\n", hipGetErrorString(e), grid);
}
```
